# Optimizing an MI355X kernel written in HIP

```python
import jax
import jax.numpy as jnp
from jax import lax
import numpy as np


D_MODEL = 1024
BATCH = 4
SEQ = 8192
DEPTH = 4

GRID_W = 64
CTX_LEN = 256
HEAD_DIM = 64
D_MIX = D_MODEL
CONV_HEADS = 4
CONV_W = CONV_HEADS * HEAD_DIM
CONV_K = 3
SG_HEADS = 4
SG_W = SG_HEADS * HEAD_DIM
SG_CHUNK = 128
NA_HEADS = 4
NA_W = NA_HEADS * HEAD_DIM
NA_KH_MAX = 8
NA_KW = 16
MLA_HEADS = 4
MLA_NOPE = 64
MLA_ROPE = 32
MLA_V = 64
MLA_Q_RANK = 256
MLA_KV_RANK = 128
MLA_W = MLA_HEADS * MLA_V
MLA_SCALE = (MLA_NOPE + MLA_ROPE) ** -0.5
ATTN_QBLOCK = 128
ROPE_BASE = 10000.0
IN_CONV = 3 * CONV_W
IN_SG = 2 * SG_W
IN_NA = 3 * NA_W
IN_MLA = MLA_Q_RANK + MLA_KV_RANK + MLA_ROPE
SG0 = IN_CONV
NA0 = SG0 + IN_SG
MLA0 = NA0 + IN_NA
IN_COLS = MLA0 + IN_MLA
N_GROUPS = 4
EXPERTS_PER_GROUP = 8
N_EXPERTS = N_GROUPS * EXPERTS_PER_GROUP
TOP_K_INNER = 2
D_EXPERT = 512
MOE_BLOCK = 128
N_MOD = 6
EPS = 1e-6

kernel_name = 'hybrid_flow_backbone'


def rms_norm(x, g):
    xf = x.astype(jnp.float32)
    y = xf * lax.rsqrt(jnp.mean(xf * xf, axis=-1, keepdims=True) + EPS)
    return (y * g.astype(jnp.float32)).astype(x.dtype)


def layer_norm_plain(x):
    xf = x.astype(jnp.float32)
    mu = jnp.mean(xf, axis=-1, keepdims=True)
    var = jnp.mean(jnp.square(xf - mu), axis=-1, keepdims=True)
    return ((xf - mu) * lax.rsqrt(var + EPS)).astype(x.dtype)


def modulate(h, shift, scale):
    return h * (1.0 + scale) + shift


def split_heads(t, n_heads):
    return t.reshape(t.shape[:-1] + (n_heads, t.shape[-1] // n_heads))


def axial_rope(n_tok):
    t = jnp.arange(n_tok)
    row = (t // GRID_W).astype(jnp.float32)
    col = (t % GRID_W).astype(jnp.float32)
    n_freq = MLA_ROPE // 4
    inv_freq = ROPE_BASE ** (-jnp.arange(n_freq, dtype=jnp.float32) / n_freq)
    ang_r = row[:, None] * inv_freq
    ang_c = col[:, None] * inv_freq
    ang = jnp.concatenate([ang_r, ang_r, ang_c, ang_c], axis=-1)
    return jnp.cos(ang), jnp.sin(ang)


def apply_rope(x, cos, sin):
    x0, x1, x2, x3 = jnp.split(x, 4, axis=-1)
    rot = jnp.concatenate([-x1, x0, -x3, x2], axis=-1)
    return (x.astype(jnp.float32) * cos + rot.astype(jnp.float32) * sin).astype(x.dtype)


def short_conv_mixer(z, conv_w):
    b_gate, c_gate, hx = jnp.split(z, 3, axis=-1)
    u = c_gate * hx
    y = lax.conv_general_dilated(
        u, conv_w[:, None, :].astype(u.dtype), window_strides=(1,),
        padding=((CONV_K // 2, CONV_K // 2),), dimension_numbers=('NWC', 'WIO', 'NWC'),
        feature_group_count=CONV_W)
    return b_gate * y


def chunk_gating_mixer(z, sg_w, sg_b):
    bsz, n, _ = z.shape
    u, v = jnp.split(jax.nn.gelu(z), 2, axis=-1)
    v = layer_norm_plain(v).reshape(bsz, n // SG_CHUNK, SG_CHUNK, SG_HEADS, HEAD_DIM)
    v = jnp.einsum('hpq,bcqhd->bcphd', sg_w, v) + sg_b.T[None, None, :, :, None]
    return u * v.reshape(bsz, n, SG_W)


def neighborhood_attention(q, k, v, k_ctx, v_ctx, rpb):
    bsz, n, n_h, dh = q.shape
    rows = n // GRID_W
    kh = min(NA_KH_MAX, rows)
    kw = NA_KW
    scale = dh ** -0.5
    r = jnp.arange(rows)
    band = jnp.clip(r - kh // 2, 0, rows - kh)[:, None] + jnp.arange(kh)[None, :]
    col = jnp.arange(GRID_W)
    c0 = jnp.clip(col - kw // 2, 0, GRID_W - kw)
    in_win = (col[None, :] >= c0[:, None]) & (col[None, :] < c0[:, None] + kw)
    dr = band - r[:, None] + (NA_KH_MAX - 1)
    dc = jnp.clip(col[None, :] - col[:, None] + (kw - 1), 0, 2 * kw - 2)
    bias = rpb.astype(jnp.float32)[:, dr[:, None, :, None], dc[None, :, None, :]]
    bias = jnp.where(in_win[None, None, :, None, :], bias, -jnp.inf)
    qg = q.reshape(bsz, rows, GRID_W, n_h, dh)
    k_band = k.reshape(bsz, rows, GRID_W, n_h, dh)[:, band]
    v_band = v.reshape(bsz, rows, GRID_W, n_h, dh)[:, band]
    s_loc = jnp.einsum('brqhd,brjkhd->bhrqjk', qg, k_band).astype(jnp.float32) * scale + bias[None]
    s_ctx = jnp.einsum('brqhd,bchd->bhrqc', qg, k_ctx).astype(jnp.float32) * scale
    n_loc = kh * GRID_W
    s = jnp.concatenate([s_loc.reshape(bsz, n_h, rows, GRID_W, n_loc), s_ctx], axis=-1)
    p = jax.nn.softmax(s, axis=-1).astype(v.dtype)
    p_loc = p[..., :n_loc].reshape(bsz, n_h, rows, GRID_W, kh, GRID_W)
    o = (jnp.einsum('bhrqjk,brjkhd->brqhd', p_loc, v_band)
         + jnp.einsum('bhrqc,bchd->brqhd', p[..., n_loc:], v_ctx))
    return o.reshape(bsz, n, n_h * dh)


def dense_attention(q, k, v):
    s = jnp.einsum('bqhd,bkhd->bhqk', q, k).astype(jnp.float32) * (q.shape[-1] ** -0.5)
    p = jax.nn.softmax(s, axis=-1).astype(v.dtype)
    return jnp.einsum('bhqk,bkhd->bqhd', p, v)


def mla_q(cq, q_norm_g, w_uq):
    q = split_heads(rms_norm(cq, q_norm_g) @ w_uq, MLA_HEADS)
    return q[..., :MLA_NOPE], q[..., MLA_NOPE:]


def mla_kv(ckv_kr, kv_norm_g, w_ukv):
    ckv, k_rope = ckv_kr[..., :MLA_KV_RANK], ckv_kr[..., MLA_KV_RANK:]
    kv = split_heads(rms_norm(ckv, kv_norm_g) @ w_ukv, MLA_HEADS)
    return kv[..., :MLA_NOPE], k_rope, kv[..., MLA_NOPE:]


def mla_attend(q_nope, q_rope, k_nope, k_rope, v):
    s = (jnp.einsum('bqhd,bkhd->bhqk', q_nope, k_nope)
         + jnp.einsum('bqhr,bkr->bhqk', q_rope, k_rope)).astype(jnp.float32) * MLA_SCALE
    p = jax.nn.softmax(s, axis=-1).astype(v.dtype)
    return jnp.einsum('bhqk,bkhd->bqhd', p, v)


def mla_blocked(q_nope, q_rope, k_nope, k_rope, v):
    bsz, n = q_nope.shape[:2]
    nb = n // ATTN_QBLOCK

    def to_blocks(t):
        return jnp.moveaxis(t.reshape((bsz, nb, ATTN_QBLOCK) + t.shape[2:]), 1, 0)

    o = lax.map(lambda qs: mla_attend(qs[0], qs[1], k_nope, k_rope, v),
                (to_blocks(q_nope), to_blocks(q_rope)))
    return jnp.moveaxis(o, 0, 1).reshape(bsz, n, MLA_W)


def merge_groups(ys, out_norm_g, w_out):
    normed = []
    off = 0
    for y in ys:
        w = y.shape[-1]
        normed.append(rms_norm(y, out_norm_g[off:off + w]))
        off += w
    return jnp.concatenate(normed, axis=-1) @ w_out


def hier_moe(h, w_grp, b_grp, w_exp, b_exp, w_gate, w_up, w_down):
    n_tok, d = h.shape
    hf = h.astype(jnp.float32)
    grp_logits = hf @ w_grp.astype(jnp.float32) + b_grp.astype(jnp.float32)
    grp_prob = jax.nn.softmax(grp_logits, axis=-1)
    _, g_sel = lax.top_k(grp_logits, 1)
    p_grp = jnp.take_along_axis(grp_prob, g_sel, axis=-1)
    exp_logits = (hf @ w_exp.astype(jnp.float32) + b_exp.astype(jnp.float32)).reshape(
        n_tok, N_GROUPS, EXPERTS_PER_GROUP)
    idx = jnp.broadcast_to(g_sel[:, :, None], (n_tok, 1, EXPERTS_PER_GROUP))
    in_grp = jnp.take_along_axis(exp_logits, idx, axis=1)[:, 0]
    top_v, top_i = lax.top_k(in_grp, TOP_K_INNER)
    gates = p_grp * jax.nn.softmax(top_v, axis=-1)
    expert_id = (g_sel * EXPERTS_PER_GROUP + top_i).reshape(-1)
    n_asg = n_tok * TOP_K_INNER
    order = jnp.argsort(expert_id)
    sorted_e = expert_id[order]
    counts = jnp.bincount(expert_id, length=N_EXPERTS)
    start = jnp.cumsum(counts) - counts
    padded = (counts + MOE_BLOCK - 1) // MOE_BLOCK * MOE_BLOCK
    padded_end = jnp.cumsum(padded)
    padded_start = padded_end - padded
    dest_sorted = padded_start[sorted_e] + (jnp.arange(n_asg) - start[sorted_e])
    n_blk = -(-n_asg // MOE_BLOCK) + N_EXPERTS
    cap = n_blk * MOE_BLOCK
    row_tok = jnp.full((cap,), n_tok, jnp.int32).at[dest_sorted].set(
        (order // TOP_K_INNER).astype(jnp.int32))
    h_pad = jnp.concatenate([h, jnp.zeros((1, d), h.dtype)], axis=0)
    x_buf = h_pad[row_tok].reshape(n_blk, MOE_BLOCK, d)
    blk_expert = jnp.clip(jnp.searchsorted(padded_end, jnp.arange(n_blk) * MOE_BLOCK, side='right'),
                          0, N_EXPERTS - 1)

    def expert_block(args):
        xb, e = args
        return (jax.nn.silu(xb @ w_gate[e]) * (xb @ w_up[e])) @ w_down[e]

    y_buf = lax.map(expert_block, (x_buf, blk_expert)).reshape(cap, d)
    dest = jnp.zeros((n_asg,), dest_sorted.dtype).at[order].set(dest_sorted)
    y = y_buf[dest].reshape(n_tok, TOP_K_INNER, d).astype(jnp.float32) * gates[..., None]
    return jnp.sum(y, axis=1).astype(h.dtype)


def trunk_layer(x, xc, c_act, c_ctx_act, cos, sin, w_ada, b_ada, norm1_g, norm2_g, w_in,
                conv_w, sg_w, sg_b, na_rpb, mla_q_norm_g, mla_w_uq, mla_kv_norm_g, mla_w_ukv,
                out_norm_g, w_out, w_grp, b_grp, w_exp, b_exp, w_gate, w_up, w_down, update_ctx):
    bsz, n_lat, d = x.shape
    n_ctx = xc.shape[1]
    mod = c_act @ w_ada + b_ada
    mod_c = c_ctx_act @ w_ada + b_ada
    sh1, sc1, g1, sh2, sc2, g2 = jnp.split(mod[:, None, :], N_MOD, axis=-1)
    csh1, csc1, cg1, csh2, csc2, cg2 = jnp.split(mod_c, N_MOD, axis=-1)

    h = modulate(rms_norm(x, norm1_g), sh1, sc1)
    hc = modulate(rms_norm(xc, norm1_g), csh1, csc1)

    z = h @ w_in
    za, zb, zn, zd = jnp.split(z, [SG0, NA0, MLA0], axis=-1)
    if update_ctx:
        zc = hc @ w_in
        zca, zcb, zcn, zcd = jnp.split(zc, [SG0, NA0, MLA0], axis=-1)
        zcn_kv, zcd_kv = zcn[..., NA_W:], zcd[..., MLA_Q_RANK:]
    else:
        zcn_kv = hc @ w_in[:, NA0 + NA_W:MLA0]
        zcd_kv = hc @ w_in[:, MLA0 + MLA_Q_RANK:]

    ya = short_conv_mixer(za, conv_w)
    yb = chunk_gating_mixer(zb, sg_w, sg_b)
    q_na, k_na, v_na = [split_heads(t, NA_HEADS) for t in jnp.split(zn, 3, axis=-1)]
    kc_na, vc_na = [split_heads(t, NA_HEADS) for t in jnp.split(zcn_kv, 2, axis=-1)]
    yc = neighborhood_attention(q_na, k_na, v_na, kc_na, vc_na, na_rpb)
    q_nope, q_rope = mla_q(zd[..., :MLA_Q_RANK], mla_q_norm_g, mla_w_uq)
    q_rope = apply_rope(q_rope, cos[:, None, :], sin[:, None, :])
    k_nope, k_rope, v_m = mla_kv(zd[..., MLA_Q_RANK:], mla_kv_norm_g, mla_w_ukv)
    k_rope = apply_rope(k_rope, cos, sin)
    ck_nope, ck_rope, cv_m = mla_kv(zcd_kv, mla_kv_norm_g, mla_w_ukv)
    yd = mla_blocked(q_nope, q_rope,
                     jnp.concatenate([k_nope, ck_nope], axis=1),
                     jnp.concatenate([k_rope, ck_rope], axis=1),
                     jnp.concatenate([v_m, cv_m], axis=1))
    x = x + g1 * merge_groups([ya, yb, yc, yd], out_norm_g, w_out)
    h2 = modulate(rms_norm(x, norm2_g), sh2, sc2)
    if not update_ctx:
        f = hier_moe(h2.reshape(-1, d), w_grp, b_grp, w_exp, b_exp, w_gate, w_up, w_down)
        return x + g2 * f.reshape(bsz, n_lat, d), xc

    yac = short_conv_mixer(zca, conv_w)
    ybc = chunk_gating_mixer(zcb, sg_w, sg_b)
    ycc = dense_attention(split_heads(zcn[..., :NA_W], NA_HEADS), kc_na, vc_na).reshape(bsz, n_ctx, NA_W)
    cq_nope, cq_rope = mla_q(zcd[..., :MLA_Q_RANK], mla_q_norm_g, mla_w_uq)
    ydc = mla_attend(cq_nope, cq_rope, ck_nope, ck_rope, cv_m).reshape(bsz, n_ctx, MLA_W)
    xc = xc + cg1 * merge_groups([yac, ybc, ycc, ydc], out_norm_g, w_out)
    h2c = modulate(rms_norm(xc, norm2_g), csh2, csc2)
    f = hier_moe(jnp.concatenate([h2.reshape(-1, d), h2c.reshape(-1, d)], axis=0),
                 w_grp, b_grp, w_exp, b_exp, w_gate, w_up, w_down)
    x = x + g2 * f[:bsz * n_lat].reshape(bsz, n_lat, d)
    xc = xc + cg2 * f[bsz * n_lat:].reshape(bsz, n_ctx, d)
    return x, xc


def setup_inputs(seed: int = 0) -> dict:
    key = jax.random.key(seed)
    ks = jax.random.split(key, 27)
    L, D = DEPTH, D_MODEL

    def nrm(i, shape, s):
        return jax.random.normal(ks[i], shape, jnp.float32) * s

    def gain(i, shape):
        return 1.0 + nrm(i, shape, 0.1)

    return {
        'x': nrm(0, (BATCH, SEQ, D), 1.0),
        'c': nrm(1, (BATCH, D), 1.0),
        'ctx': nrm(2, (BATCH, CTX_LEN, D), 1.0),
        'c_ctx': nrm(3, (D,), 1.0),
        'w_ada': nrm(4, (L, D, N_MOD * D), 0.5 * D ** -0.5),
        'b_ada': nrm(5, (L, N_MOD * D), 0.02),
        'norm1_g': gain(6, (L, D)),
        'norm2_g': gain(7, (L, D)),
        'w_in': nrm(8, (L, D, IN_COLS), D ** -0.5),
        'conv_w': nrm(9, (L, CONV_K, CONV_W), CONV_K ** -0.5),
        'sg_w': nrm(10, (L, SG_HEADS, SG_CHUNK, SG_CHUNK), SG_CHUNK ** -0.5),
        'sg_b': gain(11, (L, SG_HEADS, SG_CHUNK)),
        'na_rpb': nrm(12, (L, NA_HEADS, 2 * NA_KH_MAX - 1, 2 * NA_KW - 1), 0.2),
        'mla_q_norm_g': gain(13, (L, MLA_Q_RANK)),
        'mla_w_uq': nrm(14, (L, MLA_Q_RANK, MLA_HEADS * (MLA_NOPE + MLA_ROPE)), MLA_Q_RANK ** -0.5),
        'mla_kv_norm_g': gain(15, (L, MLA_KV_RANK)),
        'mla_w_ukv': nrm(16, (L, MLA_KV_RANK, MLA_HEADS * (MLA_NOPE + MLA_V)), MLA_KV_RANK ** -0.5),
        'out_norm_g': gain(17, (L, D_MIX)),
        'w_out': nrm(18, (L, D_MIX, D), D_MIX ** -0.5),
        'w_grp': nrm(19, (L, D, N_GROUPS), D ** -0.5),
        'b_grp': nrm(20, (L, N_GROUPS), 0.01),
        'w_exp': nrm(21, (L, D, N_EXPERTS), D ** -0.5),
        'b_exp': nrm(22, (L, N_EXPERTS), 0.01),
        'w_gate': nrm(23, (L, N_EXPERTS, D, D_EXPERT), D ** -0.5),
        'w_up': nrm(24, (L, N_EXPERTS, D, D_EXPERT), D ** -0.5),
        'w_down': nrm(25, (L, N_EXPERTS, D_EXPERT, D), D_EXPERT ** -0.5),
        'final_norm_g': gain(26, (D,)),
    }


def reference(x, c, ctx, c_ctx, w_ada, b_ada, norm1_g, norm2_g, w_in, conv_w, sg_w, sg_b, na_rpb,
              mla_q_norm_g, mla_w_uq, mla_kv_norm_g, mla_w_ukv, out_norm_g, w_out,
              w_grp, b_grp, w_exp, b_exp, w_gate, w_up, w_down, final_norm_g):
    cos, sin = axial_rope(x.shape[1])
    c_act = jax.nn.silu(c)
    c_ctx_act = jax.nn.silu(c_ctx)
    xc = ctx
    for l in range(DEPTH):
        x, xc = trunk_layer(
            x, xc, c_act, c_ctx_act, cos, sin, w_ada[l], b_ada[l], norm1_g[l], norm2_g[l], w_in[l],
            conv_w[l], sg_w[l], sg_b[l], na_rpb[l], mla_q_norm_g[l], mla_w_uq[l], mla_kv_norm_g[l],
            mla_w_ukv[l], out_norm_g[l], w_out[l], w_grp[l], b_grp[l], w_exp[l], b_exp[l],
            w_gate[l], w_up[l], w_down[l], update_ctx=(l < DEPTH - 1))
    return rms_norm(x, final_norm_g)
```

```cpp
#include <hip/hip_runtime.h>
#include <stdint.h>
#include <string.h>

namespace nv {
constexpr int D = 1024, NB = 4, S = 8192, L = 4, C = 256, NLAT = NB * S, NCTX = NB * C, MT = NLAT + NCTX;
constexpr int ZC = 2464, SG0 = 768, NA0 = 1280, MLA0 = 2048;
constexpr int NE = 32, DE = 512;
constexpr float EPS = 1e-6f;

__device__ __forceinline__ float silu_f(float v) { return v / (1.f + expf(-v)); }
__device__ __forceinline__ float gelu_tanh(float v) { const float k = 0.7978845608028654f; return 0.5f * v * (1.f + tanhf(k * (v + 0.044715f * v * v * v))); }
__device__ __forceinline__ float wave_sum(float v) { for (int o = 32; o > 0; o >>= 1) v += __shfl_xor(v, o); return v; }
__device__ __forceinline__ float wave_max(float v) { for (int o = 32; o > 0; o >>= 1) v = fmaxf(v, __shfl_xor(v, o)); return v; }
__device__ __forceinline__ float block_sum256(float v, float* red) {
    v = wave_sum(v);
    __syncthreads();
    if ((threadIdx.x & 63) == 0) red[threadIdx.x >> 6] = v;
    __syncthreads();
    return red[0] + red[1] + red[2] + red[3];
}
__device__ __forceinline__ int mod_idx(int r) { return r < NLAT ? (r >> 13) : 4; }

__global__ void k_mod(const float* c, const float* c_ctx, const float* w_ada, const float* b_ada, float* mod) {
    const int idx = blockIdx.x * 256 + threadIdx.x;
    if (idx >= L * 5 * 6144) return;
    const int col = idx % 6144, bb = (idx / 6144) % 5, l = idx / (6144 * 5);
    const float* cv = bb < 4 ? c + bb * D : c_ctx;
    const float* w = w_ada + (size_t)l * D * 6144 + col;
    float acc = 0.f;
    for (int k = 0; k < D; ++k) acc += silu_f(cv[k]) * w[(size_t)k * 6144];
    mod[idx] = acc + b_ada[l * 6144 + col];
}

__global__ void k_norm_mod(const float* X, const float* g, const float* modl, int sh_off, int sc_off, float* H) {
    __shared__ float red[4];
    const int r = blockIdx.x, bb = mod_idx(r), tid = threadIdx.x;
    const float* x = X + (size_t)r * D; const float* m = modl + bb * 6144;
    float v[4]; float ss = 0.f;
    for (int i = 0; i < 4; ++i) { v[i] = x[tid + 256 * i]; ss += v[i] * v[i]; }
    ss = block_sum256(ss, red);
    const float rs = 1.0f / sqrtf(ss / D + EPS);
    for (int i = 0; i < 4; ++i) { const int col = tid + 256 * i; H[(size_t)r * D + col] = v[i] * rs * g[col] * (1.f + m[sc_off + col]) + m[sh_off + col]; }
}

struct GemmP {
    const float* A; const float* B; float* C; const int* list; const int* cnt; const float* aux;
    size_t b_estride;
    int lda, ldb, ldc, M, N, K, mode, pad;
};
__global__ void __launch_bounds__(256) k_gemm(GemmP p) {
    __shared__ float As[16][65];
    __shared__ float Bs[16][64];
    __shared__ int s_e, s_m0, s_base, s_cnt;
    const int tid = threadIdx.x;
    int e = 0, m0 = blockIdx.x * 64, base = 0, mtot = p.M;
    if (p.cnt) {
        if (tid == 0) {
            int t = blockIdx.x, bs = 0, fe = -1, fm0 = 0, fb = 0, fc = 0;
            for (int i = 0; i < NE; ++i) { const int c = p.cnt[i]; const int nt = (c + 63) >> 6; if (fe < 0 && t < nt) { fe = i; fm0 = t * 64; fb = bs; fc = c; } t -= nt; bs += c; }
            s_e = fe; s_m0 = fm0; s_base = fb; s_cnt = fc;
        }
        __syncthreads();
        e = s_e; m0 = s_m0; base = s_base; mtot = s_cnt;
        if (e < 0) return;
    } else if (m0 >= p.M) return;
    const int n0 = blockIdx.y * 64;
    const float* Bp = p.B + (size_t)e * p.b_estride;
    const int tx = tid & 15, ty = tid >> 4;
    float acc[4][4];
    for (int i = 0; i < 4; ++i) for (int j = 0; j < 4; ++j) acc[i][j] = 0.f;
    const int ar = tid >> 2, ak = (tid & 3) * 4;
    const float* arow = nullptr;
    if (m0 + ar < mtot) {
        const int i = m0 + ar;
        if (p.mode == 2 || p.mode == 3) arow = p.A + (size_t)(p.list[(size_t)e * MT + i] >> 1) * p.lda;
        else if (p.mode == 4) arow = p.A + (size_t)(base + i) * p.lda;
        else arow = p.A + (size_t)i * p.lda;
    }
    const int bk = tid >> 4, bn = (tid & 15) * 4;
    for (int k0 = 0; k0 < p.K; k0 += 16) {
        float4 av = make_float4(0.f, 0.f, 0.f, 0.f);
        if (arow) av = *(const float4*)(arow + k0 + ak);
        As[ak + 0][ar] = av.x; As[ak + 1][ar] = av.y; As[ak + 2][ar] = av.z; As[ak + 3][ar] = av.w;
        float4 bv = make_float4(0.f, 0.f, 0.f, 0.f);
        if (n0 + bn < p.N) bv = *(const float4*)(Bp + (size_t)(k0 + bk) * p.ldb + n0 + bn);
        *(float4*)&Bs[bk][bn] = bv;
        __syncthreads();
#pragma unroll
        for (int k = 0; k < 16; ++k) {
            float a[4], b[4];
            for (int i = 0; i < 4; ++i) a[i] = As[k][ty * 4 + i];
            for (int j = 0; j < 4; ++j) b[j] = Bs[k][tx * 4 + j];
            for (int i = 0; i < 4; ++i) for (int j = 0; j < 4; ++j) acc[i][j] += a[i] * b[j];
        }
        __syncthreads();
    }
    for (int i = 0; i < 4; ++i) {
        const int li = m0 + ty * 4 + i; if (li >= mtot) continue;
        for (int j = 0; j < 4; ++j) {
            const int n = n0 + tx * 4 + j; if (n >= p.N) continue;
            const float v = acc[i][j];
            if (p.mode == 0) p.C[(size_t)li * p.ldc + n] = v;
            else if (p.mode == 1) p.C[(size_t)li * p.ldc + n] += p.aux[mod_idx(li) * 6144 + n] * v;
            else if (p.mode == 2) p.C[(size_t)(base + li) * p.ldc + n] = v;
            else if (p.mode == 3) { float* c = p.C + (size_t)(base + li) * p.ldc + n; *c = silu_f(*c) * v; }
            else p.C[(size_t)(base + li) * p.ldc + n] = v;
        }
    }
}

__global__ void k_mixA(const float* Z, const float* conv_w, float* YC) {
    const size_t idx = (size_t)blockIdx.x * 256 + threadIdx.x;
    const int r = (int)(idx >> 8), ch = (int)(idx & 255);
    int t, n; if (r < NLAT) { t = r & 8191; n = 8192; } else { t = (r - NLAT) & 255; n = 256; }
    float acc = 0.f;
    for (int k = 0; k < 3; ++k) { const int tt = t + k - 1; if (tt >= 0 && tt < n) { const float* z = Z + (size_t)(r + k - 1) * ZC; acc += z[256 + ch] * z[512 + ch] * conv_w[k * 256 + ch]; } }
    YC[(size_t)r * D + ch] = Z[(size_t)r * ZC + ch] * acc;
}

__global__ void k_mixB_prep(const float* Z, float* VLN) {
    __shared__ float red[4];
    const int r = blockIdx.x, tid = threadIdx.x;
    const float v = gelu_tanh(Z[(size_t)r * ZC + SG0 + 256 + tid]);
    const float mean = block_sum256(v, red) * (1.f / 256.f);
    const float d = v - mean;
    const float var = block_sum256(d * d, red) * (1.f / 256.f);
    VLN[(size_t)r * 256 + tid] = d * (1.0f / sqrtf(var + EPS));
}
__global__ void k_mixB(const float* Z, const float* VLN, const float* sg_w, const float* sg_b, float* YC) {
    const size_t idx = (size_t)blockIdx.x * 256 + threadIdx.x;
    const int r = (int)(idx >> 8), col = (int)(idx & 255);
    const int rc = r & ~127, p = r & 127, hh = col >> 6;
    const float* w = sg_w + (size_t)(hh * 128 + p) * 128;
    float acc = 0.f;
    for (int q = 0; q < 128; ++q) acc += w[q] * VLN[(size_t)(rc + q) * 256 + col];
    acc += sg_b[hh * 128 + p];
    YC[(size_t)r * D + 256 + col] = gelu_tanh(Z[(size_t)r * ZC + SG0 + col]) * acc;
}

__global__ void __launch_bounds__(64) k_na(const float* Z, const float* rpb, float* YC) {
    __shared__ float qs[64]; __shared__ float sc[384]; __shared__ int kidx[384];
    const int r = blockIdx.x >> 2, h = blockIdx.x & 3, lane = threadIdx.x;
    qs[lane] = Z[(size_t)r * ZC + NA0 + h * 64 + lane];
    __syncthreads();
    int nkeys;
    if (r < NLAT) {
        const int b = r >> 13, t = r & 8191, row = t >> 6, col = t & 63;
        const int br0 = min(max(row - 4, 0), 120), c0 = min(max(col - 8, 0), 48);
        nkeys = 384;
        for (int kk = lane; kk < 384; kk += 64) {
            int kr; float bias = 0.f;
            if (kk < 128) { const int j = kk >> 4, i = kk & 15; const int krow = br0 + j, kcol = c0 + i; kr = b * 8192 + krow * 64 + kcol;
                const int dr = krow - row + 7; int dc = kcol - col + 15; dc = min(max(dc, 0), 30); bias = rpb[(h * 15 + dr) * 31 + dc]; }
            else kr = NLAT + b * 256 + (kk - 128);
            const float* zk = Z + (size_t)kr * ZC + NA0 + 256 + h * 64;
            float s = 0.f; for (int d = 0; d < 64; ++d) s += qs[d] * zk[d];
            sc[kk] = s * 0.125f + bias; kidx[kk] = kr;
        }
    } else {
        const int b = (r - NLAT) >> 8;
        nkeys = 256;
        for (int kk = lane; kk < 256; kk += 64) {
            const int kr = NLAT + b * 256 + kk;
            const float* zk = Z + (size_t)kr * ZC + NA0 + 256 + h * 64;
            float s = 0.f; for (int d = 0; d < 64; ++d) s += qs[d] * zk[d];
            sc[kk] = s * 0.125f; kidx[kk] = kr;
        }
    }
    __syncthreads();
    float m = -INFINITY; for (int kk = lane; kk < nkeys; kk += 64) m = fmaxf(m, sc[kk]);
    m = wave_max(m);
    float sum = 0.f; for (int kk = lane; kk < nkeys; kk += 64) { const float e = expf(sc[kk] - m); sc[kk] = e; sum += e; }
    sum = wave_sum(sum);
    __syncthreads();
    float o = 0.f;
    for (int kk = 0; kk < nkeys; ++kk) o += sc[kk] * Z[(size_t)kidx[kk] * ZC + NA0 + 512 + h * 64 + lane];
    YC[(size_t)r * D + 512 + h * 64 + lane] = o / sum;
}

__device__ __forceinline__ void rope_angles(int t, int i, int quarter, float& cs, float& sn) {
    const float row = (float)(t >> 6), col = (float)(t & 63);
    const float freq = powf(10000.f, -(float)i / 8.f);
    const float ang = (quarter < 2 ? row : col) * freq;
    cs = cosf(ang); sn = sinf(ang);
}
__global__ void k_mla_prep(const float* Z, const float* qg, const float* kvg, float* CQN, float* CKVN, float* KR) {
    __shared__ float red[4];
    const int r = blockIdx.x, tid = threadIdx.x;
    const float* z = Z + (size_t)r * ZC + MLA0;
    const float cq = z[tid];
    const float ssq = block_sum256(cq * cq, red);
    CQN[(size_t)r * 256 + tid] = cq * (1.0f / sqrtf(ssq / 256.f + EPS)) * qg[tid];
    const float ckv = tid < 128 ? z[256 + tid] : 0.f;
    const float ssk = block_sum256(ckv * ckv, red);
    if (tid < 128) CKVN[(size_t)r * 128 + tid] = ckv * (1.0f / sqrtf(ssk / 128.f + EPS)) * kvg[tid];
    if (tid < 32) {
        const float xv = z[384 + tid];
        float o = xv;
        if (r < NLAT) {
            const int t = r & 8191, quarter = tid >> 3, i = tid & 7;
            float cs, sn; rope_angles(t, i, quarter, cs, sn);
            const float partner = (quarter & 1) ? z[384 + tid - 8] : z[384 + tid + 8];
            o = (quarter & 1) ? (xv * cs + partner * sn) : (xv * cs - partner * sn);
        }
        KR[(size_t)r * 32 + tid] = o;
    }
}
__global__ void k_qrope(float* QM) {
    const size_t idx = (size_t)blockIdx.x * 256 + threadIdx.x;
    const int p = (int)(idx & 15), h = (int)((idx >> 4) & 3), r = (int)(idx >> 6);
    if (r >= NLAT) return;
    const int t = r & 8191, i = p & 7, base = (p < 8) ? 0 : 16, quarter = (p < 8) ? 0 : 2;
    float cs, sn; rope_angles(t, i, quarter, cs, sn);
    float* q = QM + (size_t)r * 384 + h * 96 + 64 + base;
    const float a = q[i], b = q[8 + i];
    q[i] = a * cs - b * sn; q[8 + i] = b * cs + a * sn;
}
__global__ void __launch_bounds__(128) k_mla_attn(const float* QM, const float* KV, const float* KR, float* YC) {
    __shared__ float Ks[32][96]; __shared__ float Vs[32][64];
    const int tid = threadIdx.x; int bid = blockIdx.x;
    int b, h, qrow, nk_lat;
    if (bid < 1024) { b = bid >> 8; h = (bid >> 6) & 3; qrow = b * 8192 + (bid & 63) * 128 + tid; nk_lat = 8192; }
    else { bid -= 1024; b = bid >> 3; h = (bid >> 1) & 3; qrow = NLAT + b * 256 + (bid & 1) * 128 + tid; nk_lat = 0; }
    float q[96], o[64];
#pragma unroll
    for (int d = 0; d < 96; ++d) q[d] = QM[(size_t)qrow * 384 + h * 96 + d];
#pragma unroll
    for (int d = 0; d < 64; ++d) o[d] = 0.f;
    float m = -INFINITY, l = 0.f;
    const float scale = 0.10206207261596577f;
    const int nkeys = nk_lat + 256;
    for (int k0 = 0; k0 < nkeys; k0 += 32) {
        __syncthreads();
        for (int e = tid; e < 32 * 96; e += 128) { const int kk = e / 96, d = e % 96; const int kg = k0 + kk; const int kr = kg < nk_lat ? b * 8192 + kg : NLAT + b * 256 + (kg - nk_lat);
            Ks[kk][d] = d < 64 ? KV[(size_t)kr * 512 + h * 128 + d] : KR[(size_t)kr * 32 + (d - 64)]; }
        for (int e = tid; e < 32 * 64; e += 128) { const int kk = e >> 6, d = e & 63; const int kg = k0 + kk; const int kr = kg < nk_lat ? b * 8192 + kg : NLAT + b * 256 + (kg - nk_lat);
            Vs[kk][d] = KV[(size_t)kr * 512 + h * 128 + 64 + d]; }
        __syncthreads();
        for (int c0 = 0; c0 < 32; c0 += 16) {
            float s[16]; float mx = m;
#pragma unroll
            for (int j = 0; j < 16; ++j) { float a = 0.f;
#pragma unroll
                for (int d = 0; d < 96; ++d) a += q[d] * Ks[c0 + j][d];
                s[j] = a * scale; mx = fmaxf(mx, s[j]); }
            if (mx > m) { const float f = expf(m - mx); l *= f;
#pragma unroll
                for (int d = 0; d < 64; ++d) o[d] *= f;
                m = mx; }
#pragma unroll
            for (int j = 0; j < 16; ++j) { const float pj = expf(s[j] - m); l += pj;
#pragma unroll
                for (int d = 0; d < 64; ++d) o[d] += pj * Vs[c0 + j][d]; }
        }
    }
    const float inv = 1.f / l;
#pragma unroll
    for (int d = 0; d < 64; ++d) YC[(size_t)qrow * D + 768 + h * 64 + d] = o[d] * inv;
}

__global__ void k_merge_norm(const float* YC, const float* og, float* H) {
    const int r = blockIdx.x, w = threadIdx.x >> 6, lane = threadIdx.x & 63;
    float v[4]; float ss = 0.f;
    for (int i = 0; i < 4; ++i) { v[i] = YC[(size_t)r * D + w * 256 + lane + 64 * i]; ss += v[i] * v[i]; }
    ss = wave_sum(ss);
    const float rs = 1.0f / sqrtf(ss / 256.f + EPS);
    for (int i = 0; i < 4; ++i) { const int col = w * 256 + lane + 64 * i; H[(size_t)r * D + col] = v[i] * rs * og[col]; }
}

__global__ void k_norm2_router(const float* X, const float* g, const float* modl, const float* w_grp, const float* b_grp, const float* w_exp, const float* b_exp,
                               float* H, int* cnt, int* list, int* asg_e, int* asg_pos, float* gate) {
    __shared__ float red[4]; __shared__ float part[36][4]; __shared__ float lg[36];
    const int r = blockIdx.x, bb = mod_idx(r), tid = threadIdx.x;
    const float* x = X + (size_t)r * D; const float* m = modl + bb * 6144;
    float v[4]; float ss = 0.f;
    for (int i = 0; i < 4; ++i) { v[i] = x[tid + 256 * i]; ss += v[i] * v[i]; }
    ss = block_sum256(ss, red);
    const float rs = 1.0f / sqrtf(ss / D + EPS);
    float hv[4];
    for (int i = 0; i < 4; ++i) { const int col = tid + 256 * i; hv[i] = v[i] * rs * g[col] * (1.f + m[4096 + col]) + m[3072 + col]; H[(size_t)r * D + col] = hv[i]; }
    for (int j = 0; j < 36; ++j) {
        float a = 0.f;
        for (int i = 0; i < 4; ++i) { const int col = tid + 256 * i; a += hv[i] * (j < 4 ? w_grp[col * 4 + j] : w_exp[col * 32 + (j - 4)]); }
        a = wave_sum(a);
        if ((tid & 63) == 0) part[j][tid >> 6] = a;
    }
    __syncthreads();
    if (tid < 36) lg[tid] = part[tid][0] + part[tid][1] + part[tid][2] + part[tid][3] + (tid < 4 ? b_grp[tid] : b_exp[tid - 4]);
    __syncthreads();
    if (tid == 0) {
        int gs = 0; float gm = lg[0];
        for (int j = 1; j < 4; ++j) if (lg[j] > gm) { gm = lg[j]; gs = j; }
        float se = 0.f; for (int j = 0; j < 4; ++j) se += expf(lg[j] - gm);
        const float pg = 1.f / se;
        const float* el = lg + 4 + gs * 8;
        int i1 = 0; float v1 = el[0];
        for (int j = 1; j < 8; ++j) if (el[j] > v1) { v1 = el[j]; i1 = j; }
        int i2 = -1; float v2 = -INFINITY;
        for (int j = 0; j < 8; ++j) if (j != i1 && el[j] > v2) { v2 = el[j]; i2 = j; }
        const float e2 = expf(v2 - v1);
        const float w1 = 1.f / (1.f + e2), w2 = e2 / (1.f + e2);
        const int E1 = gs * 8 + i1, E2 = gs * 8 + i2;
        const int p1 = atomicAdd(&cnt[E1], 1), p2 = atomicAdd(&cnt[E2], 1);
        list[(size_t)E1 * MT + p1] = r * 2; list[(size_t)E2 * MT + p2] = r * 2 + 1;
        asg_e[r * 2] = E1; asg_e[r * 2 + 1] = E2; asg_pos[r * 2] = p1; asg_pos[r * 2 + 1] = p2;
        gate[r * 2] = pg * w1; gate[r * 2 + 1] = pg * w2;
    }
}

__global__ void k_moe_combine(float* X, const float* Y, const float* modl, const int* cnt, const int* asg_e, const int* asg_pos, const float* gate) {
    __shared__ int base[NE];
    const int r = blockIdx.x, tid = threadIdx.x, bb = mod_idx(r);
    if (tid == 0) { int bs = 0; for (int i = 0; i < NE; ++i) { base[i] = bs; bs += cnt[i]; } }
    __syncthreads();
    const int s0 = base[asg_e[r * 2]] + asg_pos[r * 2], s1 = base[asg_e[r * 2 + 1]] + asg_pos[r * 2 + 1];
    const float g0 = gate[r * 2], g1 = gate[r * 2 + 1];
    for (int i = 0; i < 4; ++i) { const int col = tid + 256 * i;
        X[(size_t)r * D + col] += modl[bb * 6144 + 5120 + col] * (g0 * Y[(size_t)s0 * D + col] + g1 * Y[(size_t)s1 * D + col]); }
}

__global__ void k_final(const float* X, const float* g, float* out) {
    __shared__ float red[4];
    const int r = blockIdx.x, tid = threadIdx.x;
    float v[4]; float ss = 0.f;
    for (int i = 0; i < 4; ++i) { v[i] = X[(size_t)r * D + tid + 256 * i]; ss += v[i] * v[i]; }
    ss = block_sum256(ss, red);
    const float rs = 1.0f / sqrtf(ss / D + EPS);
    for (int i = 0; i < 4; ++i) { const int col = tid + 256 * i; out[(size_t)r * D + col] = v[i] * rs * g[col]; }
}
}

static void launch_gemm(hipStream_t st, const float* A, int lda, const float* B, int ldb, size_t b_estride, float* C, int ldc, int M, int N, int K, int mode,
                        const int* list, const int* cnt, const float* aux, int gx) {
    nv::GemmP p; memset(&p, 0, sizeof(p));
    p.A = A; p.B = B; p.C = C; p.list = list; p.cnt = cnt; p.aux = aux; p.b_estride = b_estride; p.lda = lda; p.ldb = ldb; p.ldc = ldc; p.M = M; p.N = N; p.K = K; p.mode = mode;
    hipLaunchKernelGGL(nv::k_gemm, dim3(gx, (N + 63) / 64), dim3(256), 0, st, p);
}

extern "C" void kernel_launch(void* const* d_in, const int* in_sizes, int n_in, void* d_out, int out_size, void* d_ws, size_t ws_size, hipStream_t stream) {
    using namespace nv;
    const float* x = (const float*)d_in[0]; const float* c = (const float*)d_in[1]; const float* ctx = (const float*)d_in[2]; const float* c_ctx = (const float*)d_in[3];
    const float* w_ada = (const float*)d_in[4]; const float* b_ada = (const float*)d_in[5]; const float* norm1_g = (const float*)d_in[6]; const float* norm2_g = (const float*)d_in[7];
    const float* w_in = (const float*)d_in[8]; const float* conv_w = (const float*)d_in[9]; const float* sg_w = (const float*)d_in[10]; const float* sg_b = (const float*)d_in[11];
    const float* na_rpb = (const float*)d_in[12]; const float* q_norm_g = (const float*)d_in[13]; const float* w_uq = (const float*)d_in[14]; const float* kv_norm_g = (const float*)d_in[15];
    const float* w_ukv = (const float*)d_in[16]; const float* out_norm_g = (const float*)d_in[17]; const float* w_out = (const float*)d_in[18]; const float* w_grp = (const float*)d_in[19];
    const float* b_grp = (const float*)d_in[20]; const float* w_exp = (const float*)d_in[21]; const float* b_exp = (const float*)d_in[22]; const float* w_gate = (const float*)d_in[23];
    const float* w_up = (const float*)d_in[24]; const float* w_down = (const float*)d_in[25]; const float* final_g = (const float*)d_in[26];
    float* out = (float*)d_out;
    char* ws = (char*)d_ws; size_t off = 0;
    auto take = [&](size_t bytes) { char* p = ws + off; off += (bytes + 255) & ~(size_t)255; return p; };
    float* X = (float*)take((size_t)MT * D * 4);
    float* H = (float*)take((size_t)MT * D * 4);
    float* Z = (float*)take((size_t)MT * ZC * 4);
    float* YC = (float*)take((size_t)MT * D * 4);
    float* QM = (float*)take((size_t)MT * 384 * 4);
    float* KV = (float*)take((size_t)MT * 512 * 4);
    float* KR = (float*)take((size_t)MT * 32 * 4);
    float* CQN = (float*)take((size_t)MT * 256 * 4);
    float* CKVN = (float*)take((size_t)MT * 128 * 4);
    float* MOD = (float*)take((size_t)L * 5 * 6144 * 4);
    int* CNT = (int*)take(NE * 4 * L);
    int* LIST = (int*)take((size_t)NE * MT * 4);
    int* ASG_E = (int*)take((size_t)MT * 2 * 4);
    int* ASG_P = (int*)take((size_t)MT * 2 * 4);
    float* GATE = (float*)take((size_t)MT * 2 * 4);
    float* Y = Z; float* H1 = YC; float* VLN = CQN;
    if (off > ws_size) return;

    hipMemcpyAsync(X, x, (size_t)NLAT * D * 4, hipMemcpyDeviceToDevice, stream);
    hipMemcpyAsync(X + (size_t)NLAT * D, ctx, (size_t)NCTX * D * 4, hipMemcpyDeviceToDevice, stream);
    hipMemsetAsync(CNT, 0, NE * 4 * L, stream);
    hipLaunchKernelGGL(k_mod, dim3((L * 5 * 6144 + 255) / 256), dim3(256), 0, stream, c, c_ctx, w_ada, b_ada, MOD);
    for (int l = 0; l < L; ++l) {
        const float* modl = MOD + (size_t)l * 5 * 6144;
        const int mrows = (l < L - 1) ? MT : NLAT;
        hipLaunchKernelGGL(k_norm_mod, dim3(MT), dim3(256), 0, stream, X, norm1_g + l * D, modl, 0, 1024, H);
        launch_gemm(stream, H, D, w_in + (size_t)l * D * ZC, ZC, 0, Z, ZC, MT, ZC, D, 0, nullptr, nullptr, nullptr, MT / 64);
        hipLaunchKernelGGL(k_mixA, dim3(MT), dim3(256), 0, stream, Z, conv_w + l * 3 * 256, YC);
        hipLaunchKernelGGL(k_mixB_prep, dim3(MT), dim3(256), 0, stream, Z, VLN);
        hipLaunchKernelGGL(k_mixB, dim3(MT), dim3(256), 0, stream, Z, VLN, sg_w + (size_t)l * 4 * 128 * 128, sg_b + l * 4 * 128, YC);
        hipLaunchKernelGGL(k_na, dim3(MT * 4), dim3(64), 0, stream, Z, na_rpb + l * 4 * 15 * 31, YC);
        hipLaunchKernelGGL(k_mla_prep, dim3(MT), dim3(256), 0, stream, Z, q_norm_g + l * 256, kv_norm_g + l * 128, CQN, CKVN, KR);
        launch_gemm(stream, CQN, 256, w_uq + (size_t)l * 256 * 384, 384, 0, QM, 384, MT, 384, 256, 0, nullptr, nullptr, nullptr, MT / 64);
        launch_gemm(stream, CKVN, 128, w_ukv + (size_t)l * 128 * 512, 512, 0, KV, 512, MT, 512, 128, 0, nullptr, nullptr, nullptr, MT / 64);
        hipLaunchKernelGGL(k_qrope, dim3(NLAT * 64 / 256), dim3(256), 0, stream, QM);
        hipLaunchKernelGGL(k_mla_attn, dim3(1024 + 32), dim3(128), 0, stream, QM, KV, KR, YC);
        hipLaunchKernelGGL(k_merge_norm, dim3(MT), dim3(256), 0, stream, YC, out_norm_g + l * D, H);
        launch_gemm(stream, H, D, w_out + (size_t)l * D * D, D, 0, X, D, MT, D, D, 1, nullptr, nullptr, modl + 2048, MT / 64);
        hipLaunchKernelGGL(k_norm2_router, dim3(mrows), dim3(256), 0, stream, X, norm2_g + l * D, modl, w_grp + (size_t)l * D * 4, b_grp + l * 4, w_exp + (size_t)l * D * 32, b_exp + l * 32,
                           H, CNT + l * NE, LIST, ASG_E, ASG_P, GATE);
        const int gx = (2 * MT) / 64 + NE;
        launch_gemm(stream, H, D, w_gate + (size_t)l * NE * D * DE, DE, (size_t)D * DE, H1, DE, 0, DE, D, 2, LIST, CNT + l * NE, nullptr, gx);
        launch_gemm(stream, H, D, w_up + (size_t)l * NE * D * DE, DE, (size_t)D * DE, H1, DE, 0, DE, D, 3, LIST, CNT + l * NE, nullptr, gx);
        launch_gemm(stream, H1, DE, w_down + (size_t)l * NE * DE * D, D, (size_t)DE * D, Y, D, 0, D, DE, 4, LIST, CNT + l * NE, nullptr, gx);
        hipLaunchKernelGGL(k_moe_combine, dim3(mrows), dim3(256), 0, stream, X, Y, modl, CNT + l * NE, ASG_E, ASG_P, GATE);
    }
    hipLaunchKernelGGL(k_final, dim3(NLAT), dim3(256), 0, stream, X, final_g, out);
}
```

```cpp
#define MK_ONE_LAUNCH 0
#include <hip/hip_runtime.h>
#include <stdint.h>
#include <string.h>
#include <stdio.h>

#define LAS __attribute__((address_space(3)))
#define GAS __attribute__((address_space(1)))
typedef unsigned short bf16_t;
typedef short bf16x8 __attribute__((ext_vector_type(8)));
typedef short s16x4 __attribute__((ext_vector_type(4)));
typedef float f32x4 __attribute__((ext_vector_type(4)));
typedef float f32x2 __attribute__((ext_vector_type(2)));
typedef float f32x16 __attribute__((ext_vector_type(16)));
typedef unsigned u32x4 __attribute__((ext_vector_type(4)));
typedef unsigned u32x2 __attribute__((ext_vector_type(2)));
typedef __bf16 bf16x2_t __attribute__((ext_vector_type(2)));

namespace mk {
constexpr int D = 1024, NB = 4, SEQ = 8192, NL = 4, CTX = 256, NLAT = NB * SEQ, NCTX = NB * CTX, MT = NLAT + NCTX;
constexpr int ZC = 2464, ZP = 2560;
constexpr int NE = 32, DE = 512;
constexpr int NTILE = 132;
constexpr int SLOT_TILES = 296, SLOT_ROWS = SLOT_TILES * 256;
constexpr float EPS = 1e-6f;
constexpr float LOG2E = 1.4426950408889634f;
constexpr float MLA_QSCALE = 0.10206207261596577f * LOG2E;
constexpr float NA_QSCALE = 0.125f * LOG2E;
constexpr int MKB = 12288, NKB = 8192, VB = 8192;

constexpr size_t MiB = 1u << 20;
constexpr size_t WS_CTL = 0, CTL_BYTES = 1 * MiB;
constexpr size_t WS_MOD = 1 * MiB;
constexpr size_t WS_ROPE = 2 * MiB;
constexpr size_t WS_RW = 3 * MiB;
constexpr size_t WS_CONV = 4 * MiB;
constexpr size_t WS_WIN = 5 * MiB;
constexpr size_t WS_WOUT = 25 * MiB;
constexpr size_t WS_WUQ = 33 * MiB;
constexpr size_t WS_WUKV = 34 * MiB;
constexpr size_t WS_SGW = 35 * MiB;
constexpr size_t WS_W1 = 36 * MiB;
constexpr size_t WS_W2 = 292 * MiB;
constexpr size_t WS_XC = 420 * MiB;
constexpr size_t WS_HB = 424 * MiB;
constexpr size_t WS_Z = 490 * MiB;
constexpr size_t WS_YC = 655 * MiB;
constexpr size_t WS_H1 = WS_Z;
constexpr size_t WS_Y = WS_Z + 74 * MiB;
constexpr size_t WS_CQN = 721 * MiB;
constexpr size_t WS_CKVN = 738 * MiB;
constexpr size_t WS_QM = 747 * MiB;
constexpr size_t WS_MK = 772 * MiB;
constexpr size_t WS_MV = 797 * MiB;
constexpr size_t WS_NK = 814 * MiB;
constexpr size_t WS_NV = 831 * MiB;
constexpr size_t WS_LIST = 848 * MiB;
constexpr size_t WS_ASG = 853 * MiB;
constexpr size_t WS_GATE = 854 * MiB;
constexpr size_t WS_END = 855 * MiB;
static_assert(WS_H1 + (size_t)SLOT_ROWS * 512 * 2 <= WS_Y && WS_Y + (size_t)SLOT_ROWS * 1024 * 2 <= WS_CQN, "moe overlay");
static_assert(WS_Z + (size_t)MT * ZP * 2 <= WS_YC && WS_YC + (size_t)MT * D * 2 <= WS_CQN, "z/yc");
constexpr int CW_BAR = 4096;
constexpr int CW_CNT = 8192;
constexpr int LDS_SCRATCH = 147456;
constexpr int LDS_MOE = 131072;
constexpr int LDS_MISC = 147456;
constexpr int LDS_BYTES = 163840;

__device__ __forceinline__ unsigned f2bf(float f) { unsigned u = __builtin_bit_cast(unsigned, f); return (u + 0x7fffu + ((u >> 16) & 1u)) >> 16; }
__device__ __forceinline__ unsigned pk2(float lo, float hi) { f32x2 v = {lo, hi}; bf16x2_t b = __builtin_convertvector(v, bf16x2_t); return __builtin_bit_cast(unsigned, b); }
__device__ __forceinline__ float bf_lo(unsigned w) { return __builtin_bit_cast(float, w << 16); }
__device__ __forceinline__ float bf_hi(unsigned w) { return __builtin_bit_cast(float, w & 0xffff0000u); }
__device__ __forceinline__ float bf1(bf16_t h) { return __builtin_bit_cast(float, (unsigned)h << 16); }
__device__ __forceinline__ float shx(float v, int o, int lane) { return __builtin_bit_cast(float, __builtin_amdgcn_ds_bpermute((lane ^ o) << 2, __builtin_bit_cast(int, v))); }
__device__ __forceinline__ unsigned shxu(unsigned v, int o, int lane) { return (unsigned)__builtin_amdgcn_ds_bpermute((lane ^ o) << 2, (int)v); }
__device__ __forceinline__ float wave_sum(float v, int lane) {
#pragma unroll
    for (int o = 1; o < 64; o <<= 1) v += shx(v, o, lane);
    return v;
}
__device__ __forceinline__ float silu_f(float v) { return v / (1.f + __expf(-v)); }
__device__ __forceinline__ float gelu_tanh(float v) { const float u = 0.7978845608028654f * (v + 0.044715f * v * v * v); const float e = __expf(2.f * u); return v * (1.f - 1.f / (e + 1.f)); }
__device__ __forceinline__ int lane_id() { int l; asm volatile("v_mbcnt_lo_u32_b32 %0, -1, 0\n\tv_mbcnt_hi_u32_b32 %0, -1, %0" : "=v"(l)); return l; }
__device__ __forceinline__ int crow(int r, int hi) { return (r & 3) + 8 * (r >> 2) + 4 * hi; }
__device__ __forceinline__ int mod_idx(int r) { return r < NLAT ? (r >> 13) : 4; }
__device__ __forceinline__ void tok_tile(int r, int& b, int& t, int& kk) {
    if (r < NLAT) { b = r >> 13; const int pos = r & 8191; t = pos >> 6; kk = pos & 63; }
    else { const int q = r - NLAT; b = q >> 8; const int pos = q & 255; t = 128 + (pos >> 6); kk = pos & 63; }
}
__device__ __forceinline__ int vtile_off(int kk, int d8) { return (d8 >> 2) * 4096 + (kk >> 4) * 1024 + (kk & 15) * 64 + (d8 & 3) * 16; }
__device__ __forceinline__ int ktile_off(int kk, int dc) { return dc * 1024 + kk * 16; }

namespace pg8 {
constexpr int BM = 256, BK = 64, HALF = 128, HTB = HALF * BK * 2, STAGE_BYTES = 8 * HTB, NXCD = 8, WGM = 8;
__host__ __device__ __forceinline__ int lds_byte(int r, int c) { const int st = (r >> 4) * 2 + (c >> 5), rr = r & 15, cc = c & 31, ob = rr * 64 + cc * 2; return st * 1024 + (ob ^ (((ob >> 9) & 1) << 5)); }
__host__ __device__ __forceinline__ void stage_rc(int b, int& R, int& C) { const int st = b / 1024, sb = b % 1024, swz = sb ^ (((sb >> 9) & 1) << 5); R = (st >> 1) * 16 + swz / 64; C = (st & 1) * 32 + (swz % 64) / 2; }
__host__ __device__ __forceinline__ int perm32(int rho) { const int n = rho >> 4, i = rho & 15; return 8 * (i >> 2) + 4 * n + (i & 3); }
struct Unit { int pm, pn, aux; };
struct Gemm { const bf16_t* A; const bf16_t* Bt; int lda; int K; };

struct StaticOrder {
    int nM, nN, nwg, G, c;
    __device__ void init(int M, int N, int G_, int c_) { nM = M / BM; nN = N / BM; nwg = nM * nN; G = G_; c = c_; }
    __device__ bool next(int i, Unit& u) const {
        const long L = (long)i * G + c; if (L >= nwg) return false;
        int wgid = (int)L; { const int q = nwg / NXCD, r = nwg % NXCD, xcd = wgid % NXCD, off = wgid / NXCD; wgid = (xcd < r ? xcd * (q + 1) : r * (q + 1) + (xcd - r) * q) + off; }
        const int nig = WGM * nN, gid = wgid / nig, fm = gid * WGM, gsz = (nM - fm) < WGM ? (nM - fm) : WGM;
        u.pm = fm + ((wgid % nig) % gsz); u.pn = (wgid % nig) / gsz; u.aux = 0; return true;
    }
};
struct PlainRows { static constexpr bool GATHER = false; int lda2; __device__ __forceinline__ unsigned tok(const Unit&, int) const { return 0u; } };

template <class Epi, class Sched, class ARows, bool ALIGN_EPI, bool SP2>
__device__ __forceinline__ void gemm_phase(LAS unsigned char* lds, const int tid, const Gemm g, const Sched& S, const ARows& AR, const Epi& E) {
    const int wid = __builtin_amdgcn_readfirstlane(tid >> 6), lane = tid & 63, wr = wid >> 2, wc = wid & 3, fr = lane & 15, fq = lane >> 4;
    const int K = g.K, nt = K / BK;
    int R0, C0; stage_rc(tid * 16, R0, C0);
    const unsigned lda2 = (unsigned)AR.lda2;
    const unsigned aLane = ARows::GATHER ? (unsigned)(C0 * 2) : (unsigned)R0 * lda2 + (unsigned)(C0 * 2);
    const unsigned voffB0 = (unsigned)(((R0 & ~31) + Epi::perm(R0 & 31)) * K + C0) * 2u;
    const size_t kstep = (size_t)(BK * 2);
    const size_t hstepB = (size_t)HALF * K * 2;
    const size_t tstepB = 2 * hstepB;
    const size_t qstepB = (size_t)64 * K * 2;
    const unsigned ldsw = (unsigned)wid * 1024u;
    const int aoff = lds_byte(wr * 64 + fr, fq * 8), boff = lds_byte(wc * 32 + fr, fq * 8);
#define PG8_SA(b, h) (((b) * 2 + (h)) * HTB)
#define PG8_SB(b, h) ((4 + (b) * 2 + (h)) * HTB)
#define PG8_STAGEB(bufoff, gbase) do { _Pragma("unroll") for (int _i = 0; _i < 2; ++_i) \
        __builtin_amdgcn_global_load_lds((const unsigned*)((const char*)(gbase) + _i * qstepB + voffB0), (LAS unsigned*)(lds + (bufoff) + ldsw + _i * 8192), 16, 0, 0); } while (0)
#define PG8_STAGEA(bufoff, pm_, tk_, h, kb) do { _Pragma("unroll") for (int _i = 0; _i < 2; ++_i) { \
        const char* _p; if constexpr (ARows::GATHER) _p = (const char*)g.A + (kb) + (size_t)(((tk_)[h] >> (16 * _i)) & 0xffffu) * lda2 + aLane; \
        else _p = (const char*)g.A + ((size_t)((pm_) * BM + (h) * HALF + _i * 64) * lda2 + (kb)) + aLane; \
        __builtin_amdgcn_global_load_lds((const unsigned*)_p, (LAS unsigned*)(lds + (bufoff) + ldsw + _i * 8192), 16, 0, 0); } } while (0)
#define PG8_LDA(dst, b, h) do { _Pragma("unroll") for (int m = 0; m < 4; ++m) _Pragma("unroll") for (int k = 0; k < 2; ++k) dst[m][k] = *(const LAS bf16x8*)(lds + PG8_SA(b, h) + aoff + m * 2048 + k * 1024); } while (0)
#define PG8_LDB(dst, b, h) do { _Pragma("unroll") for (int n = 0; n < 2; ++n) _Pragma("unroll") for (int k = 0; k < 2; ++k) dst[n][k] = *(const LAS bf16x8*)(lds + PG8_SB(b, h) + boff + n * 2048 + k * 1024); } while (0)
#define PG8_MMA(ai, bj, At, Bt) do { __builtin_amdgcn_s_setprio(1); _Pragma("unroll") for (int m = 0; m < 4; ++m) _Pragma("unroll") for (int n = 0; n < 2; ++n) _Pragma("unroll") for (int k = 0; k < 2; ++k) \
        acc[ai][bj][m][n] = __builtin_amdgcn_mfma_f32_16x16x32_bf16(Bt[n][k], At[m][k], acc[ai][bj][m][n], 0, 0, 0); __builtin_amdgcn_s_setprio(0); } while (0)
#define PG8_WAIT_V(n) asm volatile("s_waitcnt vmcnt(" #n ")" ::: "memory")
#define PG8_WAIT_L(n) asm volatile("s_waitcnt lgkmcnt(" #n ")" ::: "memory")
#define PG8_BAR __builtin_amdgcn_s_barrier()
#define PG8_SCHED __builtin_amdgcn_sched_barrier(0)
#define PG8_TOKS(tk_, u) do { if constexpr (ARows::GATHER) { _Pragma("unroll") for (int _h = 0; _h < 2; ++_h) (tk_)[_h] = AR.tok((u), _h * HALF + R0) | (AR.tok((u), _h * HALF + 64 + R0) << 16); } } while (0)
    Unit cur, nxt; int ui = 0;
    if (!S.next(0, cur)) return;
    f32x4 acc[2][2][4][2];
#pragma unroll
    for (int a = 0; a < 2; ++a)
#pragma unroll
        for (int b = 0; b < 2; ++b)
#pragma unroll
            for (int m = 0; m < 4; ++m)
#pragma unroll
                for (int n = 0; n < 2; ++n) acc[a][b][m][n] = (f32x4){0.f, 0.f, 0.f, 0.f};
    bf16x8 At[4][2], B0[2][2], B1[2][2];
    unsigned tkC[2] = {0u, 0u}, tkN[2] = {0u, 0u};
    PG8_TOKS(tkC, cur);
    const char* cB = (const char*)g.Bt + (size_t)cur.pn * tstepB;
    static_assert(SP2, "only the SP2 loop is kept");
    PG8_STAGEB(PG8_SB(0, 0), cB); PG8_STAGEB(PG8_SB(0, 1), cB + hstepB); PG8_STAGEA(PG8_SA(0, 0), cur.pm, tkC, 0, 0); PG8_STAGEA(PG8_SA(0, 1), cur.pm, tkC, 1, 0);
    if (wr == 1) PG8_BAR;
    PG8_WAIT_V(2); PG8_BAR;
    PG8_STAGEB(PG8_SB(1, 0), cB + kstep); PG8_STAGEA(PG8_SA(1, 0), cur.pm, tkC, 0, kstep); PG8_STAGEB(PG8_SB(1, 1), cB + hstepB + kstep);
    PG8_WAIT_V(6); PG8_BAR;
    for (;;) {
        const bool has_next = S.next(ui + 1, nxt);
        if (!has_next) nxt = cur;
        PG8_TOKS(tkN, nxt);
        const char* nB = (const char*)g.Bt + (size_t)nxt.pn * tstepB;
        for (int t = 0; t < nt; t += 2) {
            const bool last = (t == nt - 2);
            const size_t k1 = (size_t)(t + 1) * kstep;
            const size_t k2 = last ? 0 : (size_t)(t + 2) * kstep, k3 = k2 + kstep;
            const int pm2 = last ? nxt.pm : cur.pm;
            unsigned tk2[2];
#pragma unroll
            for (int _h = 0; _h < 2; ++_h) tk2[_h] = last ? tkN[_h] : tkC[_h];
            const char* b2 = last ? nB : cB + (size_t)(t + 2) * kstep; const char* b3 = b2 + kstep;
            PG8_LDB(B0, 0, 0); PG8_LDB(B1, 0, 1); PG8_SCHED; PG8_LDA(At, 0, 0); PG8_STAGEA(PG8_SA(1, 1), cur.pm, tkC, 1, k1);
            PG8_WAIT_V(8); PG8_WAIT_L(0); PG8_BAR; PG8_MMA(0, 0, At, B0); PG8_MMA(0, 1, At, B1); PG8_BAR; PG8_SCHED;
            PG8_LDA(At, 0, 1); PG8_STAGEB(PG8_SB(0, 0), b2); PG8_STAGEB(PG8_SB(0, 1), b2 + hstepB); PG8_STAGEA(PG8_SA(0, 0), pm2, tk2, 0, k2);
            PG8_WAIT_V(8); PG8_WAIT_L(0); PG8_BAR; PG8_MMA(1, 0, At, B0); PG8_MMA(1, 1, At, B1); PG8_BAR; PG8_SCHED;
            PG8_LDB(B0, 1, 0); PG8_LDB(B1, 1, 1); PG8_SCHED; PG8_LDA(At, 1, 0); PG8_STAGEA(PG8_SA(0, 1), pm2, tk2, 1, k2);
            PG8_WAIT_V(8); PG8_WAIT_L(0); PG8_BAR; PG8_MMA(0, 0, At, B0); PG8_MMA(0, 1, At, B1); PG8_BAR; PG8_SCHED;
            PG8_LDA(At, 1, 1); PG8_STAGEB(PG8_SB(1, 0), b3); PG8_STAGEB(PG8_SB(1, 1), b3 + hstepB); PG8_STAGEA(PG8_SA(1, 0), pm2, tk2, 0, k3);
            PG8_WAIT_V(8); PG8_WAIT_L(0); PG8_BAR; PG8_MMA(1, 0, At, B0); PG8_MMA(1, 1, At, B1); PG8_BAR; PG8_SCHED;
        }
        if constexpr (ALIGN_EPI) { if (wr == 0) PG8_BAR; }
        E(acc, cur, wr, wc, fr, fq);
        if (!has_next) break;
#pragma unroll
        for (int a = 0; a < 2; ++a)
#pragma unroll
            for (int b = 0; b < 2; ++b)
#pragma unroll
                for (int m = 0; m < 4; ++m)
#pragma unroll
                    for (int n = 0; n < 2; ++n) acc[a][b][m][n] = (f32x4){0.f, 0.f, 0.f, 0.f};
        cur = nxt; cB = nB; ++ui;
#pragma unroll
        for (int _h = 0; _h < 2; ++_h) tkC[_h] = tkN[_h];
        if constexpr (ALIGN_EPI) { if (wr == 1) PG8_BAR; }
    }
    PG8_WAIT_V(0);
    if constexpr (!ALIGN_EPI) { if (wr == 0) PG8_BAR; }
    PG8_BAR;
#undef PG8_SA
#undef PG8_SB
#undef PG8_STAGEA
#undef PG8_STAGEB
#undef PG8_LDA
#undef PG8_LDB
#undef PG8_MMA
#undef PG8_WAIT_V
#undef PG8_WAIT_L
#undef PG8_BAR
#undef PG8_SCHED
#undef PG8_TOKS
}
}
__device__ __forceinline__ u32x4 pack8(const f32x4 a, const f32x4 b, float s) { u32x4 w; w.x = pk2(a[0] * s, a[1] * s); w.y = pk2(a[2] * s, a[3] * s); w.z = pk2(b[0] * s, b[1] * s); w.w = pk2(b[2] * s, b[3] * s); return w; }

struct EpiZ {
    static __host__ __device__ __forceinline__ int perm(int r) { return pg8::perm32(r); }
    bf16_t* Z; unsigned char* NK; unsigned char* NV;
    __device__ __forceinline__ void operator()(const f32x4 (&acc)[2][2][4][2], const pg8::Unit& u, int wr, int wc, int fr, int fq) const {
        const int pn = u.pn;
        if (pn == 6 || pn == 7) {
            unsigned char* base = pn == 6 ? NK : NV;
            #pragma unroll
            for (int ai = 0; ai < 2; ++ai)
            #pragma unroll
            for (int m = 0; m < 4; ++m) { const int rl = ai * 128 + wr * 64 + m * 16 + fr; const int row = u.pm * 256 + rl; (void)rl; (void)row;
                int b, t, kk; tok_tile(row, b, t, kk);
#pragma unroll
                for (int bj = 0; bj < 2; ++bj) { const int col = bj * 128 + wc * 32 + 8 * fq; const int h = col >> 6, d8 = (col & 63) >> 3;
                    unsigned char* dst = base + ((size_t)((b * 4 + h) * NTILE + t)) * 8192 + (pn == 6 ? ktile_off(kk, d8) : vtile_off(kk, d8));
                    *(u32x4*)dst = pack8(acc[ai][bj][m][0], acc[ai][bj][m][1], 1.f); }
            }
        } else {
            const float s = pn == 5 ? NA_QSCALE : 1.f;
            #pragma unroll
            for (int ai = 0; ai < 2; ++ai)
            #pragma unroll
            for (int m = 0; m < 4; ++m) { const int rl = ai * 128 + wr * 64 + m * 16 + fr; const int row = u.pm * 256 + rl; (void)rl; (void)row;
                bf16_t* rowp = Z + (size_t)row * ZP + pn * 256 + wc * 32 + 8 * fq;
#pragma unroll
                for (int bj = 0; bj < 2; ++bj) *(u32x4*)(rowp + bj * 128) = pack8(acc[ai][bj][m][0], acc[ai][bj][m][1], s);
            }
        }
    }
};

struct EpiQ {
    static __host__ __device__ __forceinline__ int perm(int r) { return pg8::perm32(r); }
    bf16_t* QM;
    __device__ __forceinline__ void operator()(const f32x4 (&acc)[2][2][4][2], const pg8::Unit& u, int wr, int wc, int fr, int fq) const {
#pragma unroll
        for (int ai = 0; ai < 2; ++ai)
#pragma unroll
            for (int m = 0; m < 4; ++m) { const int row = u.pm * 256 + ai * 128 + wr * 64 + m * 16 + fr;
#pragma unroll
                for (int bj = 0; bj < 2; ++bj) { const int cb = u.pn * 256 + bj * 128 + wc * 32;
                    if (cb < 384) *(u32x4*)(QM + (size_t)row * 384 + cb + 8 * fq) = pack8(acc[ai][bj][m][0], acc[ai][bj][m][1], MLA_QSCALE); } }
    }
};

struct EpiKV {
    static __host__ __device__ __forceinline__ int perm(int r) { return pg8::perm32(r); }
    unsigned char* MK; unsigned char* MV;
    __device__ __forceinline__ void operator()(const f32x4 (&acc)[2][2][4][2], const pg8::Unit& u, int wr, int wc, int fr, int fq) const {
        #pragma unroll
        for (int ai = 0; ai < 2; ++ai)
        #pragma unroll
        for (int m = 0; m < 4; ++m) { const int rl = ai * 128 + wr * 64 + m * 16 + fr; const int row = u.pm * 256 + rl; (void)rl; (void)row;
            int b, t, kk; tok_tile(row, b, t, kk);
#pragma unroll
            for (int bj = 0; bj < 2; ++bj) { const int col = u.pn * 256 + bj * 128 + wc * 32 + 8 * fq; const int h = col >> 7, isv = (col >> 6) & 1, d8 = (col & 63) >> 3;
                const size_t tile = (size_t)((b * 4 + h) * NTILE + t);
                unsigned char* dst = isv ? (MV + tile * VB + vtile_off(kk, d8)) : (MK + tile * MKB + ktile_off(kk, d8));
                *(u32x4*)dst = pack8(acc[ai][bj][m][0], acc[ai][bj][m][1], 1.f); }
        }
    }
};

struct EpiOut {
    static __host__ __device__ __forceinline__ int perm(int r) { return pg8::perm32(r); }
    const float* res_lat; const float* res_ctx; float* x_lat; float* x_ctx; const float* g1;
    __device__ __forceinline__ void operator()(const f32x4 (&acc)[2][2][4][2], const pg8::Unit& u, int wr, int wc, int fr, int fq) const {
        const bool latent = u.pm < 128;
        const int bb = latent ? (u.pm >> 5) : 4;
        const float* rbase = latent ? res_lat : res_ctx - (size_t)NLAT * D;
        float* xbase = latent ? x_lat : x_ctx - (size_t)NLAT * D;
        const int c0 = u.pn * 256 + wc * 32 + 8 * fq;
        f32x4 gv[2][2];
#pragma unroll
        for (int bj = 0; bj < 2; ++bj)
#pragma unroll
            for (int n = 0; n < 2; ++n) gv[bj][n] = *(const f32x4*)(g1 + bb * 6144 + c0 + bj * 128 + 4 * n);
        #pragma unroll
        for (int ai = 0; ai < 2; ++ai)
        #pragma unroll
        for (int m = 0; m < 4; ++m) { const int rl = ai * 128 + wr * 64 + m * 16 + fr; const int row = u.pm * 256 + rl; (void)rl; (void)row;
#pragma unroll
            for (int bj = 0; bj < 2; ++bj)
#pragma unroll
                for (int n = 0; n < 2; ++n) { const size_t off = (size_t)row * D + c0 + bj * 128 + 4 * n;
                    const f32x4 r = *(const f32x4*)(rbase + off); *(f32x4*)(xbase + off) = r + gv[bj][n] * acc[ai][bj][m][n]; }
        }
    }
};

struct EpiMoe1 {
    static __host__ __device__ __forceinline__ int perm(int r) { return pg8::perm32(r); }
    bf16_t* H1;
    __device__ __forceinline__ void operator()(const f32x4 (&acc)[2][2][4][2], const pg8::Unit& u, int wr, int wc, int fr, int fq) const {
        #pragma unroll
        for (int ai = 0; ai < 2; ++ai)
        #pragma unroll
        for (int m = 0; m < 4; ++m) { const int rl = ai * 128 + wr * 64 + m * 16 + fr; const int row = u.pm * 256 + rl; (void)rl; (void)row;
            f32x4 h0; f32x4 h1;
#pragma unroll
            for (int e = 0; e < 4; ++e) { h0[e] = silu_f(acc[ai][0][m][0][e]) * acc[ai][1][m][0][e]; h1[e] = silu_f(acc[ai][0][m][1][e]) * acc[ai][1][m][1][e]; }
            *(u32x4*)(H1 + (size_t)row * DE + (u.pn & 3) * 128 + wc * 32 + 8 * fq) = pack8(h0, h1, 1.f);
        }
    }
};
struct EpiMoe2 {
    static __host__ __device__ __forceinline__ int perm(int r) { return pg8::perm32(r); }
    bf16_t* Y;
    __device__ __forceinline__ void operator()(const f32x4 (&acc)[2][2][4][2], const pg8::Unit& u, int wr, int wc, int fr, int fq) const {
        #pragma unroll
        for (int ai = 0; ai < 2; ++ai)
        #pragma unroll
        for (int m = 0; m < 4; ++m) { const int rl = ai * 128 + wr * 64 + m * 16 + fr; const int row = u.pm * 256 + rl; (void)rl; (void)row;
            bf16_t* rowp = Y + (size_t)row * D + (u.pn & 3) * 256 + wc * 32 + 8 * fq;
#pragma unroll
            for (int bj = 0; bj < 2; ++bj) *(u32x4*)(rowp + bj * 128) = pack8(acc[ai][bj][m][0], acc[ai][bj][m][1], 1.f);
        }
    }
};

struct MoeOrder {
    const LAS int* tb; int G, c;
    __device__ __forceinline__ bool next(int i, pg8::Unit& u) const {
        const int L = i * G + c; const int ntl = tb[32];
        if (L >= ntl * 4) return false;
        const int rt = L >> 2; int e = 0;
        for (int j = 1; j < 32; ++j) e += (tb[j] <= rt) ? 1 : 0;
        u.pm = rt; u.pn = e * 4 + (L & 3); u.aux = e; return true;
    }
};
struct MoeRows1 {
    static constexpr bool GATHER = true;
    int lda2; const LAS int* tb; const LAS int* cn; const int* list;
    __device__ __forceinline__ unsigned tok(const pg8::Unit& u, int lr) const {
        const int e = u.aux; int j = (u.pm - tb[e]) * 256 + lr; const int c = cn[e]; j = j < c ? j : c - 1;
        return (unsigned)(list[(size_t)e * MT + j] >> 1);
    }
};
__device__ __forceinline__ s16x4 vtr(const LAS unsigned char* p) { typedef short v4i16_t __attribute__((ext_vector_type(4))); return __builtin_bit_cast(s16x4, __builtin_amdgcn_ds_read_tr16_b64_v4i16((LAS v4i16_t*)p)); }

struct NaInfo { int active_lo, active_hi;
                int qrow, qcol, c0; const LAS float* tab; };

template <int KS, bool ISNA, bool ROPEQ>
__device__ __forceinline__ void attn_unit(LAS unsigned char* lds, const int tid, const bf16_t* Qw  , int qpitch,
                                          const unsigned char* Kt, const unsigned char* Vt, int a0, int na, int nb, bf16_t* Ow, const NaInfo& ni, const float* rope_row  ) {
    constexpr int KB = KS * 2048, TB = KB + 8192, NPK = KB / 1024, NP = NPK + 8;
    const int lane = tid & 63, r32 = lane & 31, hi = lane >> 5; const int wid = __builtin_amdgcn_readfirstlane(tid >> 6);
    const int NT = na + nb;
#define TIX(i) ((i) < na ? a0 + (i) : 128 + (i) - na)
#define ISSUE(i, b) do { const int tx_ = TIX(i); _Pragma("unroll") for (int pp = 0; pp < 3; ++pp) { const int p_ = wid + 8 * pp; if (p_ < NP) { \
        const unsigned char* src_ = (p_ < NPK) ? (Kt + (size_t)tx_ * KB + p_ * 1024) : (Vt + (size_t)tx_ * VB + (p_ - NPK) * 1024); \
        __builtin_amdgcn_global_load_lds((const unsigned*)(src_ + lane * 16), (LAS unsigned*)(lds + (b) * TB + p_ * 1024), 16, 0, 0); } } } while (0)
    ISSUE(0, 0);
    bf16x8 qf[KS];
#pragma unroll
    for (int s = 0; s < KS; ++s) qf[s] = *(const bf16x8*)(Qw + (size_t)r32 * qpitch + s * 16 + hi * 8);
    if constexpr (ROPEQ) {
        static_assert(KS == 6, "rope only on the MLA query");
        const float* rt = rope_row + (size_t)r32 * 32;
        const float sg = hi ? 1.f : -1.f;
#pragma unroll
        for (int s = 4; s < 6; ++s) {
            u32x4 w = __builtin_bit_cast(u32x4, qf[s]); u32x4 pw; u32x4 ow;
#pragma unroll
            for (int e = 0; e < 4; ++e) pw[e] = shxu(w[e], 32, lane);
#pragma unroll
            for (int e = 0; e < 4; ++e) { const f32x4 cs = *(const f32x4*)(rt + (s - 4) * 16 + 4 * e);
                const float lo = bf_lo(w[e]) * cs[0] + sg * bf_lo(pw[e]) * cs[1], hh = bf_hi(w[e]) * cs[2] + sg * bf_hi(pw[e]) * cs[3];
                ow[e] = pk2(lo, hh); }
            qf[s] = __builtin_bit_cast(bf16x8, ow);
        }
    }
    f32x16 o0 = {}, o1 = {};
    float mrun = -1e30f, lrun = 0.f;
    asm volatile("s_waitcnt vmcnt(0)" ::: "memory");
    __syncthreads();
    for (int i = 0; i < NT; ++i) {
        const int b = i & 1;
        if (i + 1 < NT) ISSUE(i + 1, b ^ 1);
        bool active = true; int dr = 0;
        if (ISNA && i < na) { const int krow = a0 + i; active = (krow >= ni.active_lo) && (krow <= ni.active_hi); dr = krow - ni.qrow + 7; }
        if (active) {
            const LAS unsigned char* kb = lds + b * TB + hi * 1024 + r32 * 16;
            f32x16 p0 = {}, p1 = {};
#pragma unroll
            for (int s = 0; s < KS; ++s) {
                const bf16x8 k0 = *(const LAS bf16x8*)(kb + s * 2048);
                const bf16x8 k1 = *(const LAS bf16x8*)(kb + s * 2048 + 512);
                p0 = __builtin_amdgcn_mfma_f32_32x32x16_bf16(k0, qf[s], p0, 0, 0, 0);
                p1 = __builtin_amdgcn_mfma_f32_32x32x16_bf16(k1, qf[s], p1, 0, 0, 0);
            }
            if (ISNA && i < na) {
                const LAS float* trow = ni.tab + dr * 31;
#pragma unroll
                for (int r = 0; r < 16; ++r) {
                    const int kc0 = crow(r, hi), kc1 = kc0 + 32;
                    int i0 = kc0 - ni.qcol + 15; i0 = i0 < 0 ? 0 : (i0 > 30 ? 30 : i0);
                    int i1 = kc1 - ni.qcol + 15; i1 = i1 < 0 ? 0 : (i1 > 30 ? 30 : i1);
                    const float b0 = trow[i0], b1 = trow[i1];
                    p0[r] = ((unsigned)(kc0 - ni.c0) < 16u) ? p0[r] + b0 : -1e30f;
                    p1[r] = ((unsigned)(kc1 - ni.c0) < 16u) ? p1[r] + b1 : -1e30f;
                }
            }
            float mx = fmaxf(p0[0], p1[0]);
#pragma unroll
            for (int r = 1; r < 16; ++r) mx = fmaxf(mx, fmaxf(p0[r], p1[r]));
            mx = fmaxf(mx, shx(mx, 32, lane));
            const float mnew = fmaxf(mrun, mx);
            const float alpha = __builtin_amdgcn_exp2f(mrun - mnew);
            mrun = mnew;
            float ps = 0.f;
#pragma unroll
            for (int r = 0; r < 16; ++r) { p0[r] = __builtin_amdgcn_exp2f(p0[r] - mnew); p1[r] = __builtin_amdgcn_exp2f(p1[r] - mnew); ps += p0[r] + p1[r]; }
            lrun = lrun * alpha + ps;
#pragma unroll
            for (int r = 0; r < 16; ++r) { o0[r] *= alpha; o1[r] *= alpha; }
            bf16x8 pf[4];
            { u32x4 w;
              w.x = pk2(p0[0], p0[1]); w.y = pk2(p0[2], p0[3]); w.z = pk2(p0[4], p0[5]); w.w = pk2(p0[6], p0[7]); pf[0] = __builtin_bit_cast(bf16x8, w);
              w.x = pk2(p0[8], p0[9]); w.y = pk2(p0[10], p0[11]); w.z = pk2(p0[12], p0[13]); w.w = pk2(p0[14], p0[15]); pf[1] = __builtin_bit_cast(bf16x8, w);
              w.x = pk2(p1[0], p1[1]); w.y = pk2(p1[2], p1[3]); w.z = pk2(p1[4], p1[5]); w.w = pk2(p1[6], p1[7]); pf[2] = __builtin_bit_cast(bf16x8, w);
              w.x = pk2(p1[8], p1[9]); w.y = pk2(p1[10], p1[11]); w.z = pk2(p1[12], p1[13]); w.w = pk2(p1[14], p1[15]); pf[3] = __builtin_bit_cast(bf16x8, w); }
            const LAS unsigned char* vb = lds + b * TB + KB + ((lane >> 4) & 1) * 32 + (lane & 3) * 8 + (4 * hi + ((lane & 15) >> 2)) * 64;
#pragma unroll
            for (int ks = 0; ks < 4; ++ks) {
                const s16x4 a0l = vtr(vb + ks * 1024), a0h = vtr(vb + ks * 1024 + 512);
                const s16x4 a1l = vtr(vb + 4096 + ks * 1024), a1h = vtr(vb + 4096 + ks * 1024 + 512);
                const bf16x8 va0 = {a0l[0], a0l[1], a0l[2], a0l[3], a0h[0], a0h[1], a0h[2], a0h[3]};
                const bf16x8 va1 = {a1l[0], a1l[1], a1l[2], a1l[3], a1h[0], a1h[1], a1h[2], a1h[3]};
                o0 = __builtin_amdgcn_mfma_f32_32x32x16_bf16(va0, pf[ks], o0, 0, 0, 0);
                o1 = __builtin_amdgcn_mfma_f32_32x32x16_bf16(va1, pf[ks], o1, 0, 0, 0);
            }
        }
        asm volatile("s_waitcnt vmcnt(0)" ::: "memory");
        __syncthreads();
    }
    const float ltot = lrun + shx(lrun, 32, lane);
    const float inv = 1.0f / ltot;
    bf16_t* orow = Ow + (size_t)r32 * D;
#pragma unroll
    for (int g = 0; g < 4; ++g) {
        u32x2 w0, w1;
        w0.x = pk2(o0[4 * g] * inv, o0[4 * g + 1] * inv); w0.y = pk2(o0[4 * g + 2] * inv, o0[4 * g + 3] * inv);
        w1.x = pk2(o1[4 * g] * inv, o1[4 * g + 1] * inv); w1.y = pk2(o1[4 * g + 2] * inv, o1[4 * g + 3] * inv);
        *(u32x2*)(orow + 8 * g + 4 * hi) = w0;
        *(u32x2*)(orow + 32 + 8 * g + 4 * hi) = w1;
    }
#undef TIX
#undef ISSUE
}
#define XB_TMO      128
#define XB_XCNT(j)  (256  + 64 * (j))
#define XB_XSUB(j)  (1280 + 64 * (j))
#define XB_XGEN(j)  (2304 + 64 * (j))
#define XB_TOP      3328
#define XB_TOPGEN   3392
#define XCD_BAR_WORDS 3456
#define XB_SPIN_CAP (1u << 18)
__device__ __forceinline__ unsigned xb_ld(unsigned* p)              { return __hip_atomic_load(p, __ATOMIC_RELAXED, __HIP_MEMORY_SCOPE_AGENT); }
__device__ __forceinline__ unsigned xb_add(unsigned* p, unsigned v) { return __hip_atomic_fetch_add(p, v, __ATOMIC_RELAXED, __HIP_MEMORY_SCOPE_AGENT); }
__device__ __forceinline__ unsigned xb_xcc_id() { return (unsigned)__builtin_amdgcn_s_getreg((3 << 11) | 20) & 0xFu; }
#define XB_SPIN(cond, bar) do { unsigned _sp = 0; while (cond) { __builtin_amdgcn_s_sleep(1); \
    if ((++_sp & 255u) == 0u) { if (xb_ld(&(bar)[XB_TMO])) break; if (_sp > XB_SPIN_CAP) { atomicAdd(&(bar)[XB_TMO], 1u); break; } } } } while (0)
struct XcdBarrier { unsigned* bar; unsigned x; volatile LAS unsigned* st; };
__device__ __forceinline__ XcdBarrier xcd_barrier_post(unsigned* bar, volatile LAS unsigned* st, int tid) {
    XcdBarrier b; b.bar = bar; b.x = xb_xcc_id(); b.st = st;
    if (tid == 0) (void)xb_add(&bar[XB_XCNT(b.x)], 1u);
    return b;
}
__device__ __forceinline__ void xcd_barrier_complete(unsigned* bar, unsigned x, unsigned& nloc, unsigned& nx) {
    const unsigned G = gridDim.x * gridDim.y * gridDim.z;
    unsigned sum, cnt, mine, sp = 0u;
    for (;;) {
        sum = 0u; cnt = 0u; mine = 0u;
#pragma unroll
        for (unsigned j = 0; j < 16; ++j) { const unsigned c = xb_ld(&bar[XB_XCNT(j)]); sum += c; cnt += (c > 0u) ? 1u : 0u; mine = (j == x) ? c : mine; }
        if (sum == G) break;
        __builtin_amdgcn_s_sleep(1);
        if ((++sp & 255u) == 0u) { if (xb_ld(&bar[XB_TMO])) break; if (sp > XB_SPIN_CAP) { atomicAdd(&bar[XB_TMO], 1u); break; } }
    }
    nloc = mine > 0u ? mine : 1u; nx = cnt > 0u ? cnt : 1u;
}
__device__ __forceinline__ void xcd_barrier(const XcdBarrier& b, int tid) {
    asm volatile("s_waitcnt vmcnt(0)" ::: "memory");
    __syncthreads();
    if (tid == 0) {
        unsigned* bar = b.bar;
        __builtin_amdgcn_s_waitcnt(0);
        unsigned nloc = b.st[0], nx = b.st[1];
        if (nloc == 0u) { xcd_barrier_complete(bar, b.x, nloc, nx); b.st[0] = nloc; b.st[1] = nx; }
        const unsigned old = xb_add(&bar[XB_XSUB(b.x)], 1u);
        const unsigned gen = old / nloc;
        if (old + 1u == (gen + 1u) * nloc) {
            __builtin_amdgcn_fence(__ATOMIC_RELEASE, "agent");
            asm volatile("s_waitcnt vmcnt(0)" ::: "memory");
            const unsigned og = xb_add(&bar[XB_TOP], 1u);
            const unsigned tg = og / nx;
            if (og + 1u == (tg + 1u) * nx) xb_add(&bar[XB_TOPGEN], 1u);
            else XB_SPIN(xb_ld(&bar[XB_TOPGEN]) == tg, bar);
            __builtin_amdgcn_fence(__ATOMIC_ACQUIRE, "agent");
            xb_add(&bar[XB_XGEN(b.x)], 1u);
            asm volatile("s_waitcnt vmcnt(0)" ::: "memory");
        } else {
            XB_SPIN(xb_ld(&bar[XB_XGEN(b.x)]) == gen, bar);
            __builtin_amdgcn_fence(__ATOMIC_ACQUIRE, "agent");
            asm volatile("s_waitcnt vmcnt(0)" ::: "memory");
        }
    }
    __syncthreads();
}

struct Args { const float* in[27]; float* out; unsigned char* ws; int l_lo, l_hi, ph_lo, ph_hi, flags, pad; };
enum { I_X = 0, I_C, I_CTX, I_CCTX, I_WADA, I_BADA, I_N1G, I_N2G, I_WIN, I_CONVW, I_SGW, I_SGB, I_RPB, I_QNG, I_WUQ, I_KVNG, I_WUKV, I_ONG, I_WOUT, I_WGRP, I_BGRP, I_WEXP, I_BEXP, I_WGATE, I_WUP, I_WDOWN, I_FNG };

struct Frame {
    LAS unsigned char* lds; unsigned char* ws; float* out;
    int tid, lane, wave, G, vcu, gw, NGW, bx, wave0;
};

__device__ __forceinline__ void transpose_item(const float* W, int ldw, int K, bf16_t* WT, int k0, int n0, int drow, LAS float* scr, int lane) {
#pragma unroll 8
    for (int i = 0; i < 32; ++i) { const int kk = 2 * i + (lane >> 5); scr[kk * 33 + (lane & 31)] = W[(size_t)(k0 + kk) * ldw + n0 + (lane & 31)]; }
    asm volatile("s_waitcnt lgkmcnt(0)" ::: "memory");
    const int c = lane & 7;
#pragma unroll
    for (int j = 0; j < 4; ++j) { const int n = (lane >> 3) + 8 * j; const LAS float* s = scr + (8 * c) * 33 + n;
        u32x4 o; o.x = pk2(s[0 * 33], s[1 * 33]); o.y = pk2(s[2 * 33], s[3 * 33]); o.z = pk2(s[4 * 33], s[5 * 33]); o.w = pk2(s[6 * 33], s[7 * 33]);
        *(u32x4*)(WT + (size_t)(drow + n) * K + k0 + 8 * c) = o; }
    asm volatile("s_waitcnt lgkmcnt(0)" ::: "memory");
}

__device__ __forceinline__ void phase_prologue(Frame& F, const Args& A) {
    LAS float* scr = (LAS float*)(F.lds + F.wave * 8448);
    unsigned char* ws = F.ws;
    constexpr int IT_IN = 16 * 77, IT_OUT = 16 * 32, IT_UQ = 4 * 12, IT_UKV = 2 * 16, IT_G = 16 * 16, IT_D = 8 * 32;
    constexpr int IT_LAYER = IT_IN + IT_OUT + IT_UQ + IT_UKV + NE * (2 * IT_G + IT_D);
    for (int it = F.gw; it < NL * IT_LAYER; it += F.NGW) {
        const int l = it / IT_LAYER; int r = it % IT_LAYER;
        if (r < IT_IN) { const int kb = r / 77, nb = r % 77; transpose_item(A.in[I_WIN] + (size_t)l * D * ZC, ZC, D, (bf16_t*)(ws + WS_WIN) + (size_t)l * ZP * D, 64 * kb, 32 * nb, 32 * nb, scr, F.lane); continue; } r -= IT_IN;
        if (r < IT_OUT) { const int kb = r / 32, nb = r % 32; transpose_item(A.in[I_WOUT] + (size_t)l * D * D, D, D, (bf16_t*)(ws + WS_WOUT) + (size_t)l * D * D, 64 * kb, 32 * nb, 32 * nb, scr, F.lane); continue; } r -= IT_OUT;
        if (r < IT_UQ) { const int kb = r / 12, nb = r % 12; transpose_item(A.in[I_WUQ] + (size_t)l * 256 * 384, 384, 256, (bf16_t*)(ws + WS_WUQ) + (size_t)l * 512 * 256, 64 * kb, 32 * nb, 32 * nb, scr, F.lane); continue; } r -= IT_UQ;
        if (r < IT_UKV) { const int kb = r / 16, nb = r % 16; transpose_item(A.in[I_WUKV] + (size_t)l * 128 * 512, 512, 128, (bf16_t*)(ws + WS_WUKV) + (size_t)l * 512 * 128, 64 * kb, 32 * nb, 32 * nb, scr, F.lane); continue; } r -= IT_UKV;
        const int e = r / (2 * IT_G + IT_D); r %= (2 * IT_G + IT_D);
        const size_t le = (size_t)l * NE + e;
        if (r < 2 * IT_G) { const int up = r >= IT_G; if (up) r -= IT_G; const int kb = r / 16, nb = r % 16; const int n0 = 32 * nb;
            transpose_item(A.in[up ? I_WUP : I_WGATE] + le * D * DE, DE, D, (bf16_t*)(ws + WS_W1) + le * 1024 * 1024, 64 * kb, n0, (n0 >> 7) * 256 + (n0 & 127) + (up ? 128 : 0), scr, F.lane); continue; }
        r -= 2 * IT_G;
        { const int kb = r / 32, nb = r % 32; transpose_item(A.in[I_WDOWN] + le * DE * D, D, DE, (bf16_t*)(ws + WS_W2) + le * 1024 * 512, 64 * kb, 32 * nb, 32 * nb, scr, F.lane); }
    }
    { const int gt = F.gw * 64 + F.lane, NGT = F.NGW * 64;
      constexpr int ZW = 96 * 1024 * 2 / 16, ZQ = 128 * 256 * 2 / 16;
      for (int i = gt; i < NL * (ZW + ZQ); i += NGT) { const int l = i / (ZW + ZQ), r = i % (ZW + ZQ);
          u32x4* p = r < ZW ? (u32x4*)(ws + WS_WIN + ((size_t)l * ZP + ZC) * D * 2) + r : (u32x4*)(ws + WS_WUQ + ((size_t)l * 512 + 384) * 256 * 2) + (r - ZW);
          *p = (u32x4){0u, 0u, 0u, 0u}; }
      for (int i = gt; i < NL * 4 * 128 * 16; i += NGT) { const int ch = i & 15, row = i >> 4; const int s = ch >> 1, hi = ch & 1;
          const float* src = A.in[I_SGW] + (size_t)row * 128 + 16 * s + 4 * hi;
          u32x4 o; o.x = pk2(src[0], src[1]); o.y = pk2(src[2], src[3]); o.z = pk2(src[8], src[9]); o.w = pk2(src[10], src[11]);
          *((u32x4*)(ws + WS_SGW) + i) = o; }
      for (int i = gt; i < SEQ * 16; i += NGT) { const int t = i >> 4, p = i & 15;
          const float pos = (p < 8) ? (float)(t >> 6) : (float)(t & 63);
          const float ang = pos * powf(10000.f, -(float)(p & 7) / 8.f);
          ((f32x2*)(ws + WS_ROPE))[i] = (f32x2){cosf(ang), sinf(ang)}; }
      for (int i = gt; i < NL * 36 * 1024; i += NGT) { const int k = i & 1023, j = (i >> 10) % 36, l = i / (36 * 1024);
          ((float*)(ws + WS_RW))[i] = j < 4 ? A.in[I_WGRP][((size_t)l * D + k) * 4 + j] : A.in[I_WEXP][((size_t)l * D + k) * 32 + (j - 4)]; }
    }
    __syncthreads();
    { LAS float* red = (LAS float*)(F.lds + 8 * 8448);
      for (int it = F.vcu; it < NL * 96; it += F.G) { const int l = it / 96, col = (it % 96) * 64 + F.lane;
          const float* w = A.in[I_WADA] + (size_t)l * D * 6144 + col;
          float a0 = 0.f, a1 = 0.f, a2 = 0.f, a3 = 0.f, a4 = 0.f;
          const int kb = F.wave * 128;
#pragma unroll 16
          for (int k = 0; k < 128; ++k) { const float wv = w[(size_t)(kb + k) * 6144];
              a0 += silu_f(A.in[I_C][kb + k]) * wv; a1 += silu_f(A.in[I_C][D + kb + k]) * wv; a2 += silu_f(A.in[I_C][2 * D + kb + k]) * wv; a3 += silu_f(A.in[I_C][3 * D + kb + k]) * wv; a4 += silu_f(A.in[I_CCTX][kb + k]) * wv; }
          red[(F.wave * 5 + 0) * 64 + F.lane] = a0; red[(F.wave * 5 + 1) * 64 + F.lane] = a1; red[(F.wave * 5 + 2) * 64 + F.lane] = a2; red[(F.wave * 5 + 3) * 64 + F.lane] = a3; red[(F.wave * 5 + 4) * 64 + F.lane] = a4;
          __syncthreads();
          if (F.tid < 320) { const int bb = F.tid >> 6, ln = F.tid & 63; float s = 0.f;
#pragma unroll
              for (int wv = 0; wv < 8; ++wv) s += red[(wv * 5 + bb) * 64 + ln];
              const int cc = (it % 96) * 64 + ln;
              ((float*)(ws + WS_MOD))[((size_t)l * 5 + bb) * 6144 + cc] = s + A.in[I_BADA][l * 6144 + cc]; }
          __syncthreads(); }
    }
}

__device__ __forceinline__ void moe_tables(Frame& F, const Args& A, int l) {
    LAS int* tb = (LAS int*)(F.lds + LDS_MOE); LAS int* cn = tb + 64;
    __syncthreads();
    if (F.tid == 0) { const int* cnt = (const int*)(F.ws + WS_CTL) + CW_CNT + l * NE; int acc = 0;
        for (int e = 0; e < NE; ++e) { const int c = __hip_atomic_load(cnt + e, __ATOMIC_RELAXED, __HIP_MEMORY_SCOPE_AGENT); tb[e] = acc; cn[e] = c; acc += (c + 255) >> 8; }
        tb[32] = acc; }
    __syncthreads();
}

__device__ __forceinline__ void load_x_row(Frame& F, const Args& A, int r, int l, int lp, f32x4 (&x)[4], bool write_back) {
    const float* xr;
    if (l == 0 && lp < 0) xr = r < NLAT ? A.in[I_X] + (size_t)r * D : A.in[I_CTX] + (size_t)(r - NLAT) * D;
    else xr = r < NLAT ? F.out + (size_t)r * D : (const float*)(F.ws + WS_XC) + (size_t)(r - NLAT) * D;
#pragma unroll
    for (int i = 0; i < 4; ++i) x[i] = *(const f32x4*)(xr + 4 * F.lane + 256 * i);
    if (lp >= 0) {
        const LAS int* tb = (const LAS int*)(F.lds + LDS_MOE);
        const int* asg = (const int*)(F.ws + WS_ASG); const float* gate = (const float*)(F.ws + WS_GATE);
        const int e0 = asg[4 * r], p0 = asg[4 * r + 1], e1 = asg[4 * r + 2], p1 = asg[4 * r + 3];
        const float g0 = gate[2 * r], g1 = gate[2 * r + 1];
        const bf16_t* y0 = (const bf16_t*)(F.ws + WS_Y) + (size_t)(tb[e0] * 256 + p0) * D; const bf16_t* y1 = (const bf16_t*)(F.ws + WS_Y) + (size_t)(tb[e1] * 256 + p1) * D;
        const float* g2 = (const float*)(F.ws + WS_MOD) + ((size_t)lp * 5 + mod_idx(r)) * 6144 + 5120;
        float* xw = r < NLAT ? F.out + (size_t)r * D : (float*)(F.ws + WS_XC) + (size_t)(r - NLAT) * D;
#pragma unroll
        for (int i = 0; i < 4; ++i) { const int c = 4 * F.lane + 256 * i;
            const u32x2 a = *(const u32x2*)(y0 + c), b = *(const u32x2*)(y1 + c); const f32x4 gg = *(const f32x4*)(g2 + c);
            x[i][0] += gg[0] * (g0 * bf_lo(a.x) + g1 * bf_lo(b.x)); x[i][1] += gg[1] * (g0 * bf_hi(a.x) + g1 * bf_hi(b.x));
            x[i][2] += gg[2] * (g0 * bf_lo(a.y) + g1 * bf_lo(b.y)); x[i][3] += gg[3] * (g0 * bf_hi(a.y) + g1 * bf_hi(b.y));
            if (write_back) *(f32x4*)(xw + c) = x[i]; }
    }
}
__device__ __forceinline__ float row_rs(const f32x4 (&x)[4], int lane) {
    float ss = 0.f;
#pragma unroll
    for (int i = 0; i < 4; ++i) ss += (x[i][0] * x[i][0] + x[i][1] * x[i][1]) + (x[i][2] * x[i][2] + x[i][3] * x[i][3]);
    return 1.0f / sqrtf(wave_sum(ss, lane) * (1.f / D) + EPS);
}

__device__ __forceinline__ void phase_norm1(Frame& F, const Args& A, int l) {
    if (l > 0) moe_tables(F, A, l - 1);
    const float* g = A.in[I_N1G] + l * D;
    for (int r = F.gw; r < MT; r += F.NGW) {
        f32x4 x[4]; load_x_row(F, A, r, l, l - 1, x, true);
        const float rs = row_rs(x, F.lane);
        const float* m = (const float*)(F.ws + WS_MOD) + ((size_t)l * 5 + mod_idx(r)) * 6144;
        bf16_t* h = (bf16_t*)(F.ws + WS_HB) + (size_t)r * D;
#pragma unroll
        for (int i = 0; i < 4; ++i) { const int c = 4 * F.lane + 256 * i; const f32x4 gv = *(const f32x4*)(g + c), sc = *(const f32x4*)(m + 1024 + c), sh = *(const f32x4*)(m + c);
            const f32x4 o = x[i] * rs * gv * (sc + 1.f) + sh; u32x2 w; w.x = pk2(o[0], o[1]); w.y = pk2(o[2], o[3]); *(u32x2*)(h + c) = w; }
    }
}
__device__ __forceinline__ void phase_final(Frame& F, const Args& A) {
    moe_tables(F, A, NL - 1);
    const float* g = A.in[I_FNG];
    for (int r = F.gw; r < NLAT; r += F.NGW) {
        f32x4 x[4]; load_x_row(F, A, r, NL, NL - 1, x, false);
        const float rs = row_rs(x, F.lane);
        float* o = F.out + (size_t)r * D;
#pragma unroll
        for (int i = 0; i < 4; ++i) { const int c = 4 * F.lane + 256 * i; *(f32x4*)(o + c) = x[i] * rs * *(const f32x4*)(g + c); }
    }
}

__device__ __forceinline__ void phase_conv(Frame& F, const Args& A, int l) {
    const bf16_t* Z = (const bf16_t*)(F.ws + WS_Z); bf16_t* YC = (bf16_t*)(F.ws + WS_YC);
    const float* cw = A.in[I_CONVW] + l * 768;
    for (int it = F.vcu * 512 + F.tid; it < MT * 32; it += F.G * 512) {
        const int r = it >> 5, cg = (it & 31) * 8;
        int t, n; if (r < NLAT) { t = r & 8191; n = SEQ; } else { t = (r - NLAT) & 255; n = CTX; }
        float acc[8] = {0.f, 0.f, 0.f, 0.f, 0.f, 0.f, 0.f, 0.f};
#pragma unroll
        for (int k = 0; k < 3; ++k) { const int tt = t + k - 1;
            if (tt >= 0 && tt < n) { const bf16_t* z = Z + (size_t)(r + k - 1) * ZP; const u32x4 c = *(const u32x4*)(z + 256 + cg), hx = *(const u32x4*)(z + 512 + cg);
                const f32x4 w0 = *(const f32x4*)(cw + k * 256 + cg), w1 = *(const f32x4*)(cw + k * 256 + cg + 4);
                acc[0] += bf_lo(c.x) * bf_lo(hx.x) * w0[0]; acc[1] += bf_hi(c.x) * bf_hi(hx.x) * w0[1]; acc[2] += bf_lo(c.y) * bf_lo(hx.y) * w0[2]; acc[3] += bf_hi(c.y) * bf_hi(hx.y) * w0[3];
                acc[4] += bf_lo(c.z) * bf_lo(hx.z) * w1[0]; acc[5] += bf_hi(c.z) * bf_hi(hx.z) * w1[1]; acc[6] += bf_lo(c.w) * bf_lo(hx.w) * w1[2]; acc[7] += bf_hi(c.w) * bf_hi(hx.w) * w1[3]; } }
        const u32x4 bg = *(const u32x4*)(Z + (size_t)r * ZP + cg);
        u32x4 o; o.x = pk2(bf_lo(bg.x) * acc[0], bf_hi(bg.x) * acc[1]); o.y = pk2(bf_lo(bg.y) * acc[2], bf_hi(bg.y) * acc[3]); o.z = pk2(bf_lo(bg.z) * acc[4], bf_hi(bg.z) * acc[5]); o.w = pk2(bf_lo(bg.w) * acc[6], bf_hi(bg.w) * acc[7]);
        *(u32x4*)(YC + (size_t)r * D + cg) = o;
    }
}

__device__ __forceinline__ void phase_sg(Frame& F, const Args& A, int l) {
    const bf16_t* Z = (const bf16_t*)(F.ws + WS_Z); bf16_t* YC = (bf16_t*)(F.ws + WS_YC);
    LAS unsigned char* vt = F.lds;
    LAS float* red = (LAS float*)(F.lds + 65536);
    const int lane = F.lane, r32 = lane & 31, hi = lane >> 5, w = F.wave, h = w >> 1, pb = w & 1;
    for (int ch = F.vcu; ch < MT / 128; ch += F.G) {
        const int r0 = ch * 128;
        { const int tok = F.tid & 127, hq = F.tid >> 7;
          const bf16_t* zv = Z + (size_t)(r0 + tok) * ZP + 1024 + hq * 64;
          float f[64]; float s1 = 0.f;
#pragma unroll
          for (int c8 = 0; c8 < 8; ++c8) { const u32x4 v = *(const u32x4*)(zv + 8 * c8);
              f[8 * c8 + 0] = gelu_tanh(bf_lo(v.x)); f[8 * c8 + 1] = gelu_tanh(bf_hi(v.x)); f[8 * c8 + 2] = gelu_tanh(bf_lo(v.y)); f[8 * c8 + 3] = gelu_tanh(bf_hi(v.y));
              f[8 * c8 + 4] = gelu_tanh(bf_lo(v.z)); f[8 * c8 + 5] = gelu_tanh(bf_hi(v.z)); f[8 * c8 + 6] = gelu_tanh(bf_lo(v.w)); f[8 * c8 + 7] = gelu_tanh(bf_hi(v.w)); }
#pragma unroll
          for (int j = 0; j < 64; ++j) s1 += f[j];
          red[hq * 128 + tok] = s1;
          __syncthreads();
          const float mean = (red[tok] + red[128 + tok] + red[256 + tok] + red[384 + tok]) * (1.f / 256.f);
          float s2 = 0.f;
#pragma unroll
          for (int j = 0; j < 64; ++j) { f[j] -= mean; s2 += f[j] * f[j]; }
          __syncthreads();
          red[hq * 128 + tok] = s2;
          __syncthreads();
          const float rstd = 1.0f / sqrtf((red[tok] + red[128 + tok] + red[256 + tok] + red[384 + tok]) * (1.f / 256.f) + EPS);
          LAS unsigned char* tile = vt + (hq * 2 + (tok >> 6)) * 8192;
#pragma unroll
          for (int d8 = 0; d8 < 8; ++d8) { u32x4 o; o.x = pk2(f[8 * d8] * rstd, f[8 * d8 + 1] * rstd); o.y = pk2(f[8 * d8 + 2] * rstd, f[8 * d8 + 3] * rstd); o.z = pk2(f[8 * d8 + 4] * rstd, f[8 * d8 + 5] * rstd); o.w = pk2(f[8 * d8 + 6] * rstd, f[8 * d8 + 7] * rstd);
              *(LAS u32x4*)(tile + vtile_off(tok & 63, d8)) = o; }
        }
        bf16x8 bfr[2][8];
#pragma unroll
        for (int pn = 0; pn < 2; ++pn)
#pragma unroll
            for (int s = 0; s < 8; ++s) bfr[pn][s] = *(const bf16x8*)(F.ws + WS_SGW + ((((size_t)(l * 4 + h) * 128 + 64 * pb + 32 * pn + r32) * 8 + s) * 2 + hi) * 16);
        __syncthreads();
        f32x16 acc[2][2] = {};
        const LAS unsigned char* vb = vt + h * 16384 + ((lane >> 4) & 1) * 32 + (lane & 3) * 8 + (4 * hi + ((lane & 15) >> 2)) * 64;
#pragma unroll
        for (int s = 0; s < 8; ++s) {
            const LAS unsigned char* p = vb + (s >> 2) * 8192 + (s & 3) * 1024;
            const s16x4 a0l = vtr(p), a0h = vtr(p + 512), a1l = vtr(p + 4096), a1h = vtr(p + 4096 + 512);
            const bf16x8 va0 = {a0l[0], a0l[1], a0l[2], a0l[3], a0h[0], a0h[1], a0h[2], a0h[3]};
            const bf16x8 va1 = {a1l[0], a1l[1], a1l[2], a1l[3], a1h[0], a1h[1], a1h[2], a1h[3]};
#pragma unroll
            for (int pn = 0; pn < 2; ++pn) { acc[0][pn] = __builtin_amdgcn_mfma_f32_32x32x16_bf16(va0, bfr[pn][s], acc[0][pn], 0, 0, 0); acc[1][pn] = __builtin_amdgcn_mfma_f32_32x32x16_bf16(va1, bfr[pn][s], acc[1][pn], 0, 0, 0); }
        }
#pragma unroll
        for (int pn = 0; pn < 2; ++pn) { const int p = 64 * pb + 32 * pn + r32; const int row = r0 + p;
            const float bias = A.in[I_SGB][(l * 4 + h) * 128 + p];
#pragma unroll
            for (int db = 0; db < 2; ++db)
#pragma unroll
                for (int g = 0; g < 4; ++g) { const int d = 32 * db + 8 * g + 4 * hi;
                    const u32x2 uz = *(const u32x2*)(Z + (size_t)row * ZP + 768 + h * 64 + d);
                    const float u0 = gelu_tanh(bf_lo(uz.x)), u1 = gelu_tanh(bf_hi(uz.x)), u2 = gelu_tanh(bf_lo(uz.y)), u3 = gelu_tanh(bf_hi(uz.y));
                    u32x2 o; o.x = pk2(u0 * (acc[db][pn][4 * g] + bias), u1 * (acc[db][pn][4 * g + 1] + bias)); o.y = pk2(u2 * (acc[db][pn][4 * g + 2] + bias), u3 * (acc[db][pn][4 * g + 3] + bias));
                    *(u32x2*)(YC + (size_t)row * D + 256 + h * 64 + d) = o; } }
        __syncthreads();
    }
}

__device__ __forceinline__ void phase_mlaprep(Frame& F, const Args& A, int l) {
    const bf16_t* Z = (const bf16_t*)(F.ws + WS_Z);
    const float* qg = A.in[I_QNG] + l * 256; const float* kg = A.in[I_KVNG] + l * 128;
    const int lane = F.lane;
    for (int r = F.gw; r < MT; r += F.NGW) {
        const bf16_t* z = Z + (size_t)r * ZP + 2048;
        const u32x2 a = *(const u32x2*)(z + 4 * lane);
        const float q0 = bf_lo(a.x), q1 = bf_hi(a.x), q2 = bf_lo(a.y), q3 = bf_hi(a.y);
        const float rsq = 1.0f / sqrtf(wave_sum((q0 * q0 + q1 * q1) + (q2 * q2 + q3 * q3), lane) * (1.f / 256.f) + EPS);
        const f32x4 gq = *(const f32x4*)(qg + 4 * lane);
        u32x2 oq; oq.x = pk2(q0 * rsq * gq[0], q1 * rsq * gq[1]); oq.y = pk2(q2 * rsq * gq[2], q3 * rsq * gq[3]);
        *(u32x2*)((bf16_t*)(F.ws + WS_CQN) + (size_t)r * 256 + 4 * lane) = oq;
        const unsigned kvw = *(const unsigned*)(z + 256 + 2 * lane);
        const float k0 = bf_lo(kvw), k1 = bf_hi(kvw);
        const float rsk = 1.0f / sqrtf(wave_sum(k0 * k0 + k1 * k1, lane) * (1.f / 128.f) + EPS);
        *(unsigned*)((bf16_t*)(F.ws + WS_CKVN) + (size_t)r * 128 + 2 * lane) = pk2(k0 * rsk * kg[2 * lane], k1 * rsk * kg[2 * lane + 1]);
        const int j = lane & 31;
        const float xv = bf1(z[384 + j]);
        const float pv = shx(xv, 8, lane);
        float o = xv;
        if (r < NLAT) { const int p = (j & 7) + ((j >> 4) << 3); const f32x2 cs = ((const f32x2*)(F.ws + WS_ROPE))[(size_t)(r & 8191) * 16 + p];
            o = (j & 8) ? (xv * cs.x + pv * cs.y) : (xv * cs.x - pv * cs.y); }
        int b, t, kk; tok_tile(r, b, t, kk);
        if (lane < 32) { const bf16_t ob = (bf16_t)f2bf(o);
#pragma unroll
            for (int hh = 0; hh < 4; ++hh) *(bf16_t*)(F.ws + WS_MK + (size_t)((b * 4 + hh) * NTILE + t) * MKB + ktile_off(kk, 8 + (j >> 3)) + (j & 7) * 2) = ob; }
    }
}

__device__ __forceinline__ void phase_mergenorm(Frame& F, const Args& A, int l) {
    bf16_t* YC = (bf16_t*)(F.ws + WS_YC); const float* og = A.in[I_ONG] + l * D;
    for (int r = F.gw; r < MT; r += F.NGW) {
        bf16_t* y = YC + (size_t)r * D;
#pragma unroll
        for (int i = 0; i < 4; ++i) { const int c = 4 * F.lane + 256 * i; const u32x2 a = *(const u32x2*)(y + c);
            const float v0 = bf_lo(a.x), v1 = bf_hi(a.x), v2 = bf_lo(a.y), v3 = bf_hi(a.y);
            const float rs = 1.0f / sqrtf(wave_sum((v0 * v0 + v1 * v1) + (v2 * v2 + v3 * v3), F.lane) * (1.f / 256.f) + EPS);
            const f32x4 g = *(const f32x4*)(og + c);
            u32x2 o; o.x = pk2(v0 * rs * g[0], v1 * rs * g[1]); o.y = pk2(v2 * rs * g[2], v3 * rs * g[3]); *(u32x2*)(y + c) = o; }
    }
}

__device__ __forceinline__ void phase_router(Frame& F, const Args& A, int l) {
    LAS float* rw = (LAS float*)F.lds;
    __syncthreads();
    { const f32x4* src = (const f32x4*)((const float*)(F.ws + WS_RW) + (size_t)l * 36 * 1024);
      for (int i = F.tid; i < 36 * 256; i += 512) ((LAS f32x4*)rw)[i] = src[i]; }
    __syncthreads();
    const int nrows = (l < NL - 1) ? MT : NLAT;
    const float* g = A.in[I_N2G] + l * D; const float* bgrp = A.in[I_BGRP] + l * 4; const float* bexp = A.in[I_BEXP] + l * NE;
    int* cnt = (int*)(F.ws + WS_CTL) + CW_CNT + l * NE; int* list = (int*)(F.ws + WS_LIST); int* asg = (int*)(F.ws + WS_ASG); float* gate = (float*)(F.ws + WS_GATE);
    for (int r = F.gw; r < nrows; r += F.NGW) {
        f32x4 x[4]; load_x_row(F, A, r, l + 1, -1, x, false);
        const float rs = row_rs(x, F.lane);
        const float* m = (const float*)(F.ws + WS_MOD) + ((size_t)l * 5 + mod_idx(r)) * 6144;
        bf16_t* hrow = (bf16_t*)(F.ws + WS_HB) + (size_t)r * D;
#pragma unroll
        for (int i = 0; i < 4; ++i) { const int c = 4 * F.lane + 256 * i; const f32x4 gv = *(const f32x4*)(g + c), sc = *(const f32x4*)(m + 4096 + c), sh = *(const f32x4*)(m + 3072 + c);
            x[i] = x[i] * rs * gv * (sc + 1.f) + sh; u32x2 w; w.x = pk2(x[i][0], x[i][1]); w.y = pk2(x[i][2], x[i][3]); *(u32x2*)(hrow + c) = w; }
        float lg[4];
#pragma unroll
        for (int j = 0; j < 4; ++j) { float a = 0.f;
#pragma unroll
            for (int i = 0; i < 4; ++i) { const f32x4 wv = *(const LAS f32x4*)(rw + j * 1024 + 4 * F.lane + 256 * i); a += (x[i][0] * wv[0] + x[i][1] * wv[1]) + (x[i][2] * wv[2] + x[i][3] * wv[3]); }
            lg[j] = wave_sum(a, F.lane) + bgrp[j]; }
        int gs = 0; float gm = lg[0];
#pragma unroll
        for (int j = 1; j < 4; ++j) if (lg[j] > gm) { gm = lg[j]; gs = j; }
        float se = 0.f;
#pragma unroll
        for (int j = 0; j < 4; ++j) se += __expf(lg[j] - gm);
        const float pg = 1.f / se;
        gs = __builtin_amdgcn_readfirstlane(gs);
        float el[8];
#pragma unroll
        for (int j = 0; j < 8; ++j) { float a = 0.f; const LAS float* wr_ = rw + (4 + gs * 8 + j) * 1024;
#pragma unroll
            for (int i = 0; i < 4; ++i) { const f32x4 wv = *(const LAS f32x4*)(wr_ + 4 * F.lane + 256 * i); a += (x[i][0] * wv[0] + x[i][1] * wv[1]) + (x[i][2] * wv[2] + x[i][3] * wv[3]); }
            el[j] = wave_sum(a, F.lane) + bexp[gs * 8 + j]; }
        int i1 = 0; float v1 = el[0];
#pragma unroll
        for (int j = 1; j < 8; ++j) if (el[j] > v1) { v1 = el[j]; i1 = j; }
        int i2 = 0; float v2 = -INFINITY;
#pragma unroll
        for (int j = 0; j < 8; ++j) if (j != i1 && el[j] > v2) { v2 = el[j]; i2 = j; }
        const float e2 = __expf(v2 - v1);
        const float w1 = 1.f / (1.f + e2), w2 = e2 / (1.f + e2);
        if (F.lane == 0) {
            const int E1 = gs * 8 + i1, E2 = gs * 8 + i2;
            const int p1 = atomicAdd(&cnt[E1], 1), p2 = atomicAdd(&cnt[E2], 1);
            list[(size_t)E1 * MT + p1] = r * 2; list[(size_t)E2 * MT + p2] = r * 2 + 1;
            asg[4 * r] = E1; asg[4 * r + 1] = p1; asg[4 * r + 2] = E2; asg[4 * r + 3] = p2;
            gate[2 * r] = pg * w1; gate[2 * r + 1] = pg * w2;
        }
    }
}
__device__ __forceinline__ void phase_attn(Frame& F, const Args& A, int l) {
    const unsigned char* ws = F.ws;
    const bf16_t* Z = (const bf16_t*)(ws + WS_Z); const bf16_t* QM = (const bf16_t*)(ws + WS_QM); bf16_t* YC = (bf16_t*)(F.ws + WS_YC);
    LAS float* tab = (LAS float*)(F.lds + 40960);
    const int w = F.wave;
    const int nctx = (l < NL - 1) ? 16 : 0;
    for (int k = F.vcu; k < 512 + nctx; k += F.G) {
        const int uid = (F.G == 256 && k < 512) ? ((k & 255) * 2 + (k >> 8)) : k;
        NaInfo ni; ni.active_lo = 0; ni.active_hi = -1; ni.qrow = 0; ni.qcol = 0; ni.c0 = 0; ni.tab = tab;
        if (uid < 512) {
            const int b = uid >> 7, h = (uid >> 5) & 3, R0 = (uid & 31) * 4;
            __syncthreads();
            if (F.tid < 465) tab[F.tid] = A.in[I_RPB][(size_t)(l * 4 + h) * 465 + F.tid] * LOG2E;
            const int qrow = R0 + (w >> 1), qcol = 32 * (w & 1) + (F.lane & 31);
            const int bs = min(max(qrow - 4, 0), 120);
            ni.active_lo = bs; ni.active_hi = bs + 7; ni.qrow = qrow; ni.qcol = qcol; ni.c0 = min(max(qcol - 8, 0), 48);
            const int U0 = min(max(R0 - 4, 0), 120), U1 = min(max(R0 + 3 - 4, 0), 120) + 7;
            const int q0 = b * SEQ + qrow * 64 + 32 * (w & 1);
            const size_t tb = (size_t)(b * 4 + h) * NTILE;
            attn_unit<4, true, false>(F.lds, F.tid, Z + (size_t)q0 * ZP + 1280 + h * 64, ZP, ws + WS_NK + tb * NKB, ws + WS_NV + tb * VB, U0, U1 - U0 + 1, 4, YC + (size_t)q0 * D + 512 + h * 64, ni, nullptr);
        } else {
            const int cu = uid - 512, b = cu >> 2, h = cu & 3;
            const int q0 = NLAT + b * CTX + 32 * w;
            const size_t tb = (size_t)(b * 4 + h) * NTILE;
            attn_unit<4, false, false>(F.lds, F.tid, Z + (size_t)q0 * ZP + 1280 + h * 64, ZP, ws + WS_NK + tb * NKB, ws + WS_NV + tb * VB, 128, 4, 0, YC + (size_t)q0 * D + 512 + h * 64, ni, nullptr);
        }
    }
    for (int k = F.vcu; k < 512 + nctx; k += F.G) {
        const int uid = (F.G == 256 && k < 512) ? ((k & 255) * 2 + (k >> 8)) : k;
        NaInfo ni; ni.active_lo = 0; ni.active_hi = -1; ni.qrow = 0; ni.qcol = 0; ni.c0 = 0; ni.tab = tab;
        if (uid < 512) {
            const int b = uid >> 7, h = (uid >> 5) & 3, qb = uid & 31;
            const int q0 = b * SEQ + qb * 256 + 32 * w;
            const size_t tb = (size_t)(b * 4 + h) * NTILE;
            attn_unit<6, false, true>(F.lds, F.tid, QM + (size_t)q0 * 384 + h * 96, 384, ws + WS_MK + tb * MKB, ws + WS_MV + tb * VB, 0, NTILE, 0, YC + (size_t)q0 * D + 768 + h * 64, ni, (const float*)(ws + WS_ROPE) + (size_t)(q0 & 8191) * 32);
        } else {
            const int cu = uid - 512, b = cu >> 2, h = cu & 3;
            const int q0 = NLAT + b * CTX + 32 * w;
            const size_t tb = (size_t)(b * 4 + h) * NTILE;
            attn_unit<6, false, false>(F.lds, F.tid, QM + (size_t)q0 * 384 + h * 96, 384, ws + WS_MK + tb * MKB, ws + WS_MV + tb * VB, 128, 4, 0, YC + (size_t)q0 * D + 768 + h * 64, ni, nullptr);
        }
    }
}

__device__ __forceinline__ void frame_ids(Frame& F) {
    { int t = (F.wave0 << 6) | lane_id(); asm volatile("" : "+v"(t)); F.tid = t; } F.lane = F.tid & 63; F.wave = __builtin_amdgcn_readfirstlane(F.tid >> 6);
    int bx = blockIdx.x; asm volatile("" : "+s"(bx));
    F.G = gridDim.x; F.vcu = (bx & 7) * (F.G >> 3) + (bx >> 3); F.bx = bx;
    F.gw = F.vcu * 8 + F.wave; F.NGW = F.G * 8;
}
__global__ void __launch_bounds__(512, 2) fwd(Args args) {
    extern __shared__ __attribute__((aligned(16))) unsigned char lds_raw[];
    Frame F;
    F.lds = (LAS unsigned char*)lds_raw; F.ws = args.ws; F.out = args.out;
    F.wave0 = __builtin_amdgcn_readfirstlane((int)threadIdx.x >> 6);
    frame_ids(F);
    volatile LAS unsigned* MISC = (volatile LAS unsigned*)(F.lds + LDS_MISC);
    if (F.tid < 64) MISC[F.tid] = 0u;
    __syncthreads();
    XcdBarrier bar; bar.bar = (unsigned*)(args.ws + WS_CTL) + CW_BAR; bar.x = 0; bar.st = nullptr;
    if (args.flags & 4) bar = xcd_barrier_post((unsigned*)(args.ws + WS_CTL) + CW_BAR, MISC + 8, F.tid);
#define GRID_BAR() do { if (args.flags & 4) xcd_barrier(bar, (F.wave0 << 6) | lane_id()); } while (0)
#ifndef PHASE_MASK
#define PHASE_MASK 0xFFFF
#endif
#define IN(k) (((PHASE_MASK >> (k)) & 1) && args.ph_lo <= (k) && (k) < args.ph_hi)
    if ((PHASE_MASK & 1) && (args.flags & 1)) { phase_prologue(F, args); GRID_BAR(); }
#define LAUNDER() GAS unsigned char* wsg_ = (GAS unsigned char*)args.ws; asm volatile("" : "+s"(wsg_)); unsigned char* ws = (unsigned char*)wsg_; int l = l_; asm volatile("" : "+s"(l)); F.ws = ws; frame_ids(F)
    for (int l_ = args.l_lo; l_ < args.l_hi; ++l_) {
        if (IN(1)) { LAUNDER(); phase_norm1(F, args, l); GRID_BAR(); }
        if (IN(2)) { LAUNDER();
            pg8::Gemm g{(const bf16_t*)(ws + WS_HB), (const bf16_t*)(ws + WS_WIN) + (size_t)l * ZP * D, D, D};
            pg8::StaticOrder S; S.init(MT, ZP, F.G, F.bx); pg8::PlainRows AR{D * 2};
            EpiZ E{(bf16_t*)(ws + WS_Z), ws + WS_NK, ws + WS_NV};
            pg8::gemm_phase<EpiZ, pg8::StaticOrder, pg8::PlainRows, true, true>(F.lds, F.tid, g, S, AR, E);
            GRID_BAR();
        }
        if (IN(3)) { LAUNDER(); phase_conv(F, args, l); __syncthreads(); frame_ids(F); phase_sg(F, args, l); __syncthreads(); frame_ids(F); phase_mlaprep(F, args, l); GRID_BAR(); }
        if (IN(4)) { LAUNDER();
            { pg8::Gemm g{(const bf16_t*)(ws + WS_CQN), (const bf16_t*)(ws + WS_WUQ) + (size_t)l * 512 * 256, 256, 256};
              pg8::StaticOrder S; S.init(MT, 512, F.G, F.bx); pg8::PlainRows AR{256 * 2};
              EpiQ E{(bf16_t*)(ws + WS_QM)};
              pg8::gemm_phase<EpiQ, pg8::StaticOrder, pg8::PlainRows, true, true>(F.lds, F.tid, g, S, AR, E); }
            frame_ids(F);
            { pg8::Gemm g{(const bf16_t*)(ws + WS_CKVN), (const bf16_t*)(ws + WS_WUKV) + (size_t)l * 512 * 128, 128, 128};
              pg8::StaticOrder S; S.init(MT, 512, F.G, (F.G - 1 - F.bx)); pg8::PlainRows AR{128 * 2};
              EpiKV E{ws + WS_MK, ws + WS_MV};
              pg8::gemm_phase<EpiKV, pg8::StaticOrder, pg8::PlainRows, true, true>(F.lds, F.tid, g, S, AR, E); }
            GRID_BAR();
        }
        if (IN(5)) { LAUNDER(); phase_attn(F, args, l); GRID_BAR(); }
        if (IN(6)) { LAUNDER(); phase_mergenorm(F, args, l); GRID_BAR(); }
        if (IN(7)) { LAUNDER();
            pg8::Gemm g{(const bf16_t*)(ws + WS_YC), (const bf16_t*)(ws + WS_WOUT) + (size_t)l * D * D, D, D};
            pg8::StaticOrder S; S.init(MT, D, F.G, F.bx); pg8::PlainRows AR{D * 2};
            EpiOut E{l == 0 ? args.in[I_X] : args.out, l == 0 ? args.in[I_CTX] : (const float*)(ws + WS_XC), args.out, (float*)(ws + WS_XC), (const float*)(ws + WS_MOD) + (size_t)l * 5 * 6144 + 2048};
            pg8::gemm_phase<EpiOut, pg8::StaticOrder, pg8::PlainRows, true, true>(F.lds, F.tid, g, S, AR, E);
            GRID_BAR();
        }
        if (IN(8)) { LAUNDER(); phase_router(F, args, l); GRID_BAR(); }
        if (IN(9)) { LAUNDER();
            moe_tables(F, args, l);
            const LAS int* tb = (const LAS int*)(F.lds + LDS_MOE);
            pg8::Gemm g{(const bf16_t*)(ws + WS_HB), (const bf16_t*)(ws + WS_W1) + (size_t)l * NE * 1024 * 1024, D, D};
            MoeOrder S{tb, F.G, F.bx}; MoeRows1 AR{D * 2, tb, tb + 64, (const int*)(ws + WS_LIST)};
            EpiMoe1 E{(bf16_t*)(ws + WS_H1)};
            pg8::gemm_phase<EpiMoe1, MoeOrder, MoeRows1, true, true>(F.lds, F.tid, g, S, AR, E);
            GRID_BAR();
        }
        if (IN(10)) { LAUNDER();
            moe_tables(F, args, l);
            const LAS int* tb = (const LAS int*)(F.lds + LDS_MOE);
            pg8::Gemm g{(const bf16_t*)(ws + WS_H1), (const bf16_t*)(ws + WS_W2) + (size_t)l * NE * 1024 * 512, DE, DE};
            MoeOrder S{tb, F.G, F.bx}; pg8::PlainRows AR{DE * 2};
            EpiMoe2 E{(bf16_t*)(ws + WS_Y)};
            pg8::gemm_phase<EpiMoe2, MoeOrder, pg8::PlainRows, true, true>(F.lds, F.tid, g, S, AR, E);
            GRID_BAR();
        }
    }
    if (((PHASE_MASK >> 11) & 1) && (args.flags & 2)) { frame_ids(F); phase_final(F, args); }
#undef IN
#undef GRID_BAR
}
}

#ifndef MK_ONE_LAUNCH
#define MK_ONE_LAUNCH 1
#endif
extern "C" void kernel_launch(void* const* d_in, const int* in_sizes, int n_in, void* d_out, int out_size, void* d_ws, size_t ws_size, hipStream_t stream) {
    using namespace mk;
    static int grid = 0;
    if (grid == 0) {
        if (n_in != 27 || ws_size < WS_END) { fprintf(stderr, "kernel_launch: unexpected inputs (n_in %d, ws %zu)\n", n_in, ws_size); grid = -1; return; }
        int dev = 0, cus = 0;
        if (hipGetDevice(&dev) != hipSuccess || hipDeviceGetAttribute(&cus, hipDeviceAttributeMultiprocessorCount, dev) != hipSuccess) { grid = -1; return; }
        if (hipFuncSetAttribute((const void*)fwd, hipFuncAttributeMaxDynamicSharedMemorySize, LDS_BYTES) != hipSuccess) { fprintf(stderr, "kernel_launch: hipFuncSetAttribute failed\n"); grid = -1; return; }
        int per_cu = 0;
        if (hipOccupancyMaxActiveBlocksPerMultiprocessor(&per_cu, (const void*)fwd, 512, LDS_BYTES) != hipSuccess || per_cu < 1) fprintf(stderr, "kernel_launch: occupancy query says %d\n", per_cu);
        (void)hipGetLastError();
        grid = cus & ~7;
    }
    if (grid < 0) return;
    if (hipMemsetAsync((char*)d_ws + WS_CTL, 0, CTL_BYTES, stream) != hipSuccess) return;
    Args a; memset(&a, 0, sizeof(a));
    for (int i = 0; i < 27; ++i) a.in[i] = (const float*)d_in[i];
    a.out = (float*)d_out; a.ws = (unsigned char*)d_ws;
#if MK_ONE_LAUNCH
    a.l_lo = 0; a.l_hi = NL; a.ph_lo = 1; a.ph_hi = 11; a.flags = 1 | 2 | 4;
    hipLaunchKernelGGL(fwd, dim3(grid), dim3(512), LDS_BYTES, stream, a);
#else
    a.l_lo = 0; a.l_hi = 0; a.ph_lo = 0; a.ph_hi = 0; a.flags = 1;
    hipLaunchKernelGGL(fwd, dim3(grid), dim3(512), LDS_BYTES, stream, a);
    for (int l = 0; l < NL; ++l)
        for (int ph = 1; ph <= 10; ++ph) { a.l_lo = l; a.l_hi = l + 1; a.ph_lo = ph; a.ph_hi = ph + 1; a.flags = 0; hipLaunchKernelGGL(fwd, dim3(grid), dim3(512), LDS_BYTES, stream, a); }
    a.l_lo = 0; a.l_hi = 0; a.ph_lo = 0; a.ph_hi = 0; a.flags = 2;
    hipLaunchKernelGGL(fwd, dim3(grid), dim3(512), LDS_BYTES, stream, a);
#endif
}
```

```cpp
#define MK_ONE_LAUNCH 1
#include <hip/hip_runtime.h>
#include <stdint.h>
#include <string.h>
#include <stdio.h>

#define LAS __attribute__((address_space(3)))
#define GAS __attribute__((address_space(1)))
typedef unsigned short bf16_t;
typedef short bf16x8 __attribute__((ext_vector_type(8)));
typedef short s16x4 __attribute__((ext_vector_type(4)));
typedef float f32x4 __attribute__((ext_vector_type(4)));
typedef float f32x2 __attribute__((ext_vector_type(2)));
typedef float f32x16 __attribute__((ext_vector_type(16)));
typedef unsigned u32x4 __attribute__((ext_vector_type(4)));
typedef unsigned u32x2 __attribute__((ext_vector_type(2)));
typedef __bf16 bf16x2_t __attribute__((ext_vector_type(2)));

namespace mk {
constexpr int D = 1024, NB = 4, SEQ = 8192, NL = 4, CTX = 256, NLAT = NB * SEQ, NCTX = NB * CTX, MT = NLAT + NCTX;
constexpr int ZC = 2464, ZP = 2560;
constexpr int NE = 32, DE = 512;
constexpr int NTILE = 132;
constexpr int SLOT_TILES = 296, SLOT_ROWS = SLOT_TILES * 256;
constexpr float EPS = 1e-6f;
constexpr float LOG2E = 1.4426950408889634f;
constexpr float MLA_QSCALE = 0.10206207261596577f * LOG2E;
constexpr float NA_QSCALE = 0.125f * LOG2E;
constexpr int MKB = 12288, NKB = 8192, VB = 8192;

constexpr size_t MiB = 1u << 20;
constexpr size_t WS_CTL = 0, CTL_BYTES = 1 * MiB;
constexpr size_t WS_MOD = 1 * MiB;
constexpr size_t WS_ROPE = 2 * MiB;
constexpr size_t WS_RW = 3 * MiB;
constexpr size_t WS_CONV = 4 * MiB;
constexpr size_t WS_WIN = 5 * MiB;
constexpr size_t WS_WOUT = 25 * MiB;
constexpr size_t WS_WUQ = 33 * MiB;
constexpr size_t WS_WUKV = 34 * MiB;
constexpr size_t WS_SGW = 35 * MiB;
constexpr size_t WS_W1 = 36 * MiB;
constexpr size_t WS_W2 = 292 * MiB;
constexpr size_t WS_XC = 420 * MiB;
constexpr size_t WS_HB = 424 * MiB;
constexpr size_t WS_Z = 490 * MiB;
constexpr size_t WS_YC = 655 * MiB;
constexpr size_t WS_H1 = WS_Z;
constexpr size_t WS_Y = WS_Z + 74 * MiB;
constexpr size_t WS_CQN = 721 * MiB;
constexpr size_t WS_CKVN = 738 * MiB;
constexpr size_t WS_QM = 747 * MiB;
constexpr size_t WS_MK = 772 * MiB;
constexpr size_t WS_MV = 797 * MiB;
constexpr size_t WS_NK = 814 * MiB;
constexpr size_t WS_NV = 831 * MiB;
constexpr size_t WS_LIST = 848 * MiB;
constexpr size_t WS_ASG = 853 * MiB;
constexpr size_t WS_GATE = 854 * MiB;
constexpr size_t WS_END = 855 * MiB;
static_assert(WS_H1 + (size_t)SLOT_ROWS * 512 * 2 <= WS_Y && WS_Y + (size_t)SLOT_ROWS * 1024 * 2 <= WS_CQN, "moe overlay");
static_assert(WS_Z + (size_t)MT * ZP * 2 <= WS_YC && WS_YC + (size_t)MT * D * 2 <= WS_CQN, "z/yc");
constexpr int CW_BAR = 4096;
constexpr int CW_CNT = 8192;
constexpr int LDS_SCRATCH = 147456;
constexpr int LDS_MOE = 131072;
constexpr int LDS_MISC = 147456;
constexpr int LDS_BYTES = 163840;

__device__ __forceinline__ unsigned f2bf(float f) { unsigned u = __builtin_bit_cast(unsigned, f); return (u + 0x7fffu + ((u >> 16) & 1u)) >> 16; }
__device__ __forceinline__ unsigned pk2(float lo, float hi) { f32x2 v = {lo, hi}; bf16x2_t b = __builtin_convertvector(v, bf16x2_t); return __builtin_bit_cast(unsigned, b); }
__device__ __forceinline__ float bf_lo(unsigned w) { return __builtin_bit_cast(float, w << 16); }
__device__ __forceinline__ float bf_hi(unsigned w) { return __builtin_bit_cast(float, w & 0xffff0000u); }
__device__ __forceinline__ float bf1(bf16_t h) { return __builtin_bit_cast(float, (unsigned)h << 16); }
__device__ __forceinline__ float shx(float v, int o, int lane) { return __builtin_bit_cast(float, __builtin_amdgcn_ds_bpermute((lane ^ o) << 2, __builtin_bit_cast(int, v))); }
__device__ __forceinline__ unsigned shxu(unsigned v, int o, int lane) { return (unsigned)__builtin_amdgcn_ds_bpermute((lane ^ o) << 2, (int)v); }
__device__ __forceinline__ float wave_sum(float v, int lane) {
#pragma unroll
    for (int o = 1; o < 64; o <<= 1) v += shx(v, o, lane);
    return v;
}
__device__ __forceinline__ float silu_f(float v) { return v / (1.f + __expf(-v)); }
__device__ __forceinline__ float gelu_tanh(float v) { const float u = 0.7978845608028654f * (v + 0.044715f * v * v * v); const float e = __expf(2.f * u); return v * (1.f - 1.f / (e + 1.f)); }
__device__ __forceinline__ int lane_id() { int l; asm volatile("v_mbcnt_lo_u32_b32 %0, -1, 0\n\tv_mbcnt_hi_u32_b32 %0, -1, %0" : "=v"(l)); return l; }
__device__ __forceinline__ int crow(int r, int hi) { return (r & 3) + 8 * (r >> 2) + 4 * hi; }
__device__ __forceinline__ int mod_idx(int r) { return r < NLAT ? (r >> 13) : 4; }
__device__ __forceinline__ void tok_tile(int r, int& b, int& t, int& kk) {
    if (r < NLAT) { b = r >> 13; const int pos = r & 8191; t = pos >> 6; kk = pos & 63; }
    else { const int q = r - NLAT; b = q >> 8; const int pos = q & 255; t = 128 + (pos >> 6); kk = pos & 63; }
}
__device__ __forceinline__ int vtile_off(int kk, int d8) { return (d8 >> 2) * 4096 + (kk >> 4) * 1024 + (kk & 15) * 64 + (d8 & 3) * 16; }
__device__ __forceinline__ int ktile_off(int kk, int dc) { return dc * 1024 + kk * 16; }

namespace pg8 {
constexpr int BM = 256, BK = 64, HALF = 128, HTB = HALF * BK * 2, STAGE_BYTES = 8 * HTB, NXCD = 8, WGM = 8;
__host__ __device__ __forceinline__ int lds_byte(int r, int c) { const int st = (r >> 4) * 2 + (c >> 5), rr = r & 15, cc = c & 31, ob = rr * 64 + cc * 2; return st * 1024 + (ob ^ (((ob >> 9) & 1) << 5)); }
__host__ __device__ __forceinline__ void stage_rc(int b, int& R, int& C) { const int st = b / 1024, sb = b % 1024, swz = sb ^ (((sb >> 9) & 1) << 5); R = (st >> 1) * 16 + swz / 64; C = (st & 1) * 32 + (swz % 64) / 2; }
__host__ __device__ __forceinline__ int perm32(int rho) { const int n = rho >> 4, i = rho & 15; return 8 * (i >> 2) + 4 * n + (i & 3); }
struct Unit { int pm, pn, aux; };
struct Gemm { const bf16_t* A; const bf16_t* Bt; int lda; int K; };

struct StaticOrder {
    int nM, nN, nwg, G, c;
    __device__ void init(int M, int N, int G_, int c_) { nM = M / BM; nN = N / BM; nwg = nM * nN; G = G_; c = c_; }
    __device__ bool next(int i, Unit& u) const {
        const long L = (long)i * G + c; if (L >= nwg) return false;
        int wgid = (int)L; { const int q = nwg / NXCD, r = nwg % NXCD, xcd = wgid % NXCD, off = wgid / NXCD; wgid = (xcd < r ? xcd * (q + 1) : r * (q + 1) + (xcd - r) * q) + off; }
        const int nig = WGM * nN, gid = wgid / nig, fm = gid * WGM, gsz = (nM - fm) < WGM ? (nM - fm) : WGM;
        u.pm = fm + ((wgid % nig) % gsz); u.pn = (wgid % nig) / gsz; u.aux = 0; return true;
    }
};
struct PlainRows { static constexpr bool GATHER = false; int lda2; __device__ __forceinline__ unsigned tok(const Unit&, int) const { return 0u; } };

template <class Epi, class Sched, class ARows, bool ALIGN_EPI, bool SP2>
__device__ __forceinline__ void gemm_phase(LAS unsigned char* lds, const int tid, const Gemm g, const Sched& S, const ARows& AR, const Epi& E) {
    const int wid = __builtin_amdgcn_readfirstlane(tid >> 6), lane = tid & 63, wr = wid >> 2, wc = wid & 3, fr = lane & 15, fq = lane >> 4;
    const int K = g.K, nt = K / BK;
    int R0, C0; stage_rc(tid * 16, R0, C0);
    const unsigned lda2 = (unsigned)AR.lda2;
    const unsigned aLane = ARows::GATHER ? (unsigned)(C0 * 2) : (unsigned)R0 * lda2 + (unsigned)(C0 * 2);
    const unsigned voffB0 = (unsigned)(((R0 & ~31) + Epi::perm(R0 & 31)) * K + C0) * 2u;
    const size_t kstep = (size_t)(BK * 2);
    const size_t hstepB = (size_t)HALF * K * 2;
    const size_t tstepB = 2 * hstepB;
    const size_t qstepB = (size_t)64 * K * 2;
    const unsigned ldsw = (unsigned)wid * 1024u;
    const int aoff = lds_byte(wr * 64 + fr, fq * 8), boff = lds_byte(wc * 32 + fr, fq * 8);
#define PG8_SA(b, h) (((b) * 2 + (h)) * HTB)
#define PG8_SB(b, h) ((4 + (b) * 2 + (h)) * HTB)
#define PG8_STAGEB(bufoff, gbase) do { _Pragma("unroll") for (int _i = 0; _i < 2; ++_i) \
        __builtin_amdgcn_global_load_lds((const unsigned*)((const char*)(gbase) + _i * qstepB + voffB0), (LAS unsigned*)(lds + (bufoff) + ldsw + _i * 8192), 16, 0, 0); } while (0)
#define PG8_STAGEA(bufoff, pm_, tk_, h, kb) do { _Pragma("unroll") for (int _i = 0; _i < 2; ++_i) { \
        const char* _p; if constexpr (ARows::GATHER) _p = (const char*)g.A + (kb) + (size_t)(((tk_)[h] >> (16 * _i)) & 0xffffu) * lda2 + aLane; \
        else _p = (const char*)g.A + ((size_t)((pm_) * BM + (h) * HALF + _i * 64) * lda2 + (kb)) + aLane; \
        __builtin_amdgcn_global_load_lds((const unsigned*)_p, (LAS unsigned*)(lds + (bufoff) + ldsw + _i * 8192), 16, 0, 0); } } while (0)
#define PG8_LDA(dst, b, h) do { _Pragma("unroll") for (int m = 0; m < 4; ++m) _Pragma("unroll") for (int k = 0; k < 2; ++k) dst[m][k] = *(const LAS bf16x8*)(lds + PG8_SA(b, h) + aoff + m * 2048 + k * 1024); } while (0)
#define PG8_LDB(dst, b, h) do { _Pragma("unroll") for (int n = 0; n < 2; ++n) _Pragma("unroll") for (int k = 0; k < 2; ++k) dst[n][k] = *(const LAS bf16x8*)(lds + PG8_SB(b, h) + boff + n * 2048 + k * 1024); } while (0)
#define PG8_MMA(ai, bj, At, Bt) do { __builtin_amdgcn_s_setprio(1); _Pragma("unroll") for (int m = 0; m < 4; ++m) _Pragma("unroll") for (int n = 0; n < 2; ++n) _Pragma("unroll") for (int k = 0; k < 2; ++k) \
        acc[ai][bj][m][n] = __builtin_amdgcn_mfma_f32_16x16x32_bf16(Bt[n][k], At[m][k], acc[ai][bj][m][n], 0, 0, 0); __builtin_amdgcn_s_setprio(0); } while (0)
#define PG8_WAIT_V(n) asm volatile("s_waitcnt vmcnt(" #n ")" ::: "memory")
#define PG8_WAIT_L(n) asm volatile("s_waitcnt lgkmcnt(" #n ")" ::: "memory")
#define PG8_BAR __builtin_amdgcn_s_barrier()
#define PG8_SCHED __builtin_amdgcn_sched_barrier(0)
#define PG8_TOKS(tk_, u) do { if constexpr (ARows::GATHER) { _Pragma("unroll") for (int _h = 0; _h < 2; ++_h) (tk_)[_h] = AR.tok((u), _h * HALF + R0) | (AR.tok((u), _h * HALF + 64 + R0) << 16); } } while (0)
    Unit cur, nxt; int ui = 0;
    if (!S.next(0, cur)) return;
    f32x4 acc[2][2][4][2];
#pragma unroll
    for (int a = 0; a < 2; ++a)
#pragma unroll
        for (int b = 0; b < 2; ++b)
#pragma unroll
            for (int m = 0; m < 4; ++m)
#pragma unroll
                for (int n = 0; n < 2; ++n) acc[a][b][m][n] = (f32x4){0.f, 0.f, 0.f, 0.f};
    bf16x8 At[4][2], B0[2][2], B1[2][2];
    unsigned tkC[2] = {0u, 0u}, tkN[2] = {0u, 0u};
    PG8_TOKS(tkC, cur);
    const char* cB = (const char*)g.Bt + (size_t)cur.pn * tstepB;
    static_assert(SP2, "only the SP2 loop is kept");
    PG8_STAGEB(PG8_SB(0, 0), cB); PG8_STAGEB(PG8_SB(0, 1), cB + hstepB); PG8_STAGEA(PG8_SA(0, 0), cur.pm, tkC, 0, 0); PG8_STAGEA(PG8_SA(0, 1), cur.pm, tkC, 1, 0);
    if (wr == 1) PG8_BAR;
    PG8_WAIT_V(2); PG8_BAR;
    PG8_STAGEB(PG8_SB(1, 0), cB + kstep); PG8_STAGEA(PG8_SA(1, 0), cur.pm, tkC, 0, kstep); PG8_STAGEB(PG8_SB(1, 1), cB + hstepB + kstep);
    PG8_WAIT_V(6); PG8_BAR;
    for (;;) {
        const bool has_next = S.next(ui + 1, nxt);
        if (!has_next) nxt = cur;
        PG8_TOKS(tkN, nxt);
        const char* nB = (const char*)g.Bt + (size_t)nxt.pn * tstepB;
        for (int t = 0; t < nt; t += 2) {
            const bool last = (t == nt - 2);
            const size_t k1 = (size_t)(t + 1) * kstep;
            const size_t k2 = last ? 0 : (size_t)(t + 2) * kstep, k3 = k2 + kstep;
            const int pm2 = last ? nxt.pm : cur.pm;
            unsigned tk2[2];
#pragma unroll
            for (int _h = 0; _h < 2; ++_h) tk2[_h] = last ? tkN[_h] : tkC[_h];
            const char* b2 = last ? nB : cB + (size_t)(t + 2) * kstep; const char* b3 = b2 + kstep;
            PG8_LDB(B0, 0, 0); PG8_LDB(B1, 0, 1); PG8_SCHED; PG8_LDA(At, 0, 0); PG8_STAGEA(PG8_SA(1, 1), cur.pm, tkC, 1, k1);
            PG8_WAIT_V(8); PG8_WAIT_L(0); PG8_BAR; PG8_MMA(0, 0, At, B0); PG8_MMA(0, 1, At, B1); PG8_BAR; PG8_SCHED;
            PG8_LDA(At, 0, 1); PG8_STAGEB(PG8_SB(0, 0), b2); PG8_STAGEB(PG8_SB(0, 1), b2 + hstepB); PG8_STAGEA(PG8_SA(0, 0), pm2, tk2, 0, k2);
            PG8_WAIT_V(8); PG8_WAIT_L(0); PG8_BAR; PG8_MMA(1, 0, At, B0); PG8_MMA(1, 1, At, B1); PG8_BAR; PG8_SCHED;
            PG8_LDB(B0, 1, 0); PG8_LDB(B1, 1, 1); PG8_SCHED; PG8_LDA(At, 1, 0); PG8_STAGEA(PG8_SA(0, 1), pm2, tk2, 1, k2);
            PG8_WAIT_V(8); PG8_WAIT_L(0); PG8_BAR; PG8_MMA(0, 0, At, B0); PG8_MMA(0, 1, At, B1); PG8_BAR; PG8_SCHED;
            PG8_LDA(At, 1, 1); PG8_STAGEB(PG8_SB(1, 0), b3); PG8_STAGEB(PG8_SB(1, 1), b3 + hstepB); PG8_STAGEA(PG8_SA(1, 0), pm2, tk2, 0, k3);
            PG8_WAIT_V(8); PG8_WAIT_L(0); PG8_BAR; PG8_MMA(1, 0, At, B0); PG8_MMA(1, 1, At, B1); PG8_BAR; PG8_SCHED;
        }
        if constexpr (ALIGN_EPI) { if (wr == 0) PG8_BAR; }
        E(acc, cur, wr, wc, fr, fq);
        if (!has_next) break;
#pragma unroll
        for (int a = 0; a < 2; ++a)
#pragma unroll
            for (int b = 0; b < 2; ++b)
#pragma unroll
                for (int m = 0; m < 4; ++m)
#pragma unroll
                    for (int n = 0; n < 2; ++n) acc[a][b][m][n] = (f32x4){0.f, 0.f, 0.f, 0.f};
        cur = nxt; cB = nB; ++ui;
#pragma unroll
        for (int _h = 0; _h < 2; ++_h) tkC[_h] = tkN[_h];
        if constexpr (ALIGN_EPI) { if (wr == 1) PG8_BAR; }
    }
    PG8_WAIT_V(0);
    if constexpr (!ALIGN_EPI) { if (wr == 0) PG8_BAR; }
    PG8_BAR;
#undef PG8_SA
#undef PG8_SB
#undef PG8_STAGEA
#undef PG8_STAGEB
#undef PG8_LDA
#undef PG8_LDB
#undef PG8_MMA
#undef PG8_WAIT_V
#undef PG8_WAIT_L
#undef PG8_BAR
#undef PG8_SCHED
#undef PG8_TOKS
}
}
__device__ __forceinline__ u32x4 pack8(const f32x4 a, const f32x4 b, float s) { u32x4 w; w.x = pk2(a[0] * s, a[1] * s); w.y = pk2(a[2] * s, a[3] * s); w.z = pk2(b[0] * s, b[1] * s); w.w = pk2(b[2] * s, b[3] * s); return w; }

struct EpiZ {
    static __host__ __device__ __forceinline__ int perm(int r) { return pg8::perm32(r); }
    bf16_t* Z; unsigned char* NK; unsigned char* NV;
    __device__ __forceinline__ void operator()(const f32x4 (&acc)[2][2][4][2], const pg8::Unit& u, int wr, int wc, int fr, int fq) const {
        const int pn = u.pn;
        if (pn == 6 || pn == 7) {
            unsigned char* base = pn == 6 ? NK : NV;
            #pragma unroll
            for (int ai = 0; ai < 2; ++ai)
            #pragma unroll
            for (int m = 0; m < 4; ++m) { const int rl = ai * 128 + wr * 64 + m * 16 + fr; const int row = u.pm * 256 + rl; (void)rl; (void)row;
                int b, t, kk; tok_tile(row, b, t, kk);
#pragma unroll
                for (int bj = 0; bj < 2; ++bj) { const int col = bj * 128 + wc * 32 + 8 * fq; const int h = col >> 6, d8 = (col & 63) >> 3;
                    unsigned char* dst = base + ((size_t)((b * 4 + h) * NTILE + t)) * 8192 + (pn == 6 ? ktile_off(kk, d8) : vtile_off(kk, d8));
                    *(u32x4*)dst = pack8(acc[ai][bj][m][0], acc[ai][bj][m][1], 1.f); }
            }
        } else {
            const float s = pn == 5 ? NA_QSCALE : 1.f;
            #pragma unroll
            for (int ai = 0; ai < 2; ++ai)
            #pragma unroll
            for (int m = 0; m < 4; ++m) { const int rl = ai * 128 + wr * 64 + m * 16 + fr; const int row = u.pm * 256 + rl; (void)rl; (void)row;
                bf16_t* rowp = Z + (size_t)row * ZP + pn * 256 + wc * 32 + 8 * fq;
#pragma unroll
                for (int bj = 0; bj < 2; ++bj) *(u32x4*)(rowp + bj * 128) = pack8(acc[ai][bj][m][0], acc[ai][bj][m][1], s);
            }
        }
    }
};

struct EpiQ {
    static __host__ __device__ __forceinline__ int perm(int r) { return pg8::perm32(r); }
    bf16_t* QM;
    __device__ __forceinline__ void operator()(const f32x4 (&acc)[2][2][4][2], const pg8::Unit& u, int wr, int wc, int fr, int fq) const {
#pragma unroll
        for (int ai = 0; ai < 2; ++ai)
#pragma unroll
            for (int m = 0; m < 4; ++m) { const int row = u.pm * 256 + ai * 128 + wr * 64 + m * 16 + fr;
#pragma unroll
                for (int bj = 0; bj < 2; ++bj) { const int cb = u.pn * 256 + bj * 128 + wc * 32;
                    if (cb < 384) *(u32x4*)(QM + (size_t)row * 384 + cb + 8 * fq) = pack8(acc[ai][bj][m][0], acc[ai][bj][m][1], MLA_QSCALE); } }
    }
};

struct EpiKV {
    static __host__ __device__ __forceinline__ int perm(int r) { return pg8::perm32(r); }
    unsigned char* MK; unsigned char* MV;
    __device__ __forceinline__ void operator()(const f32x4 (&acc)[2][2][4][2], const pg8::Unit& u, int wr, int wc, int fr, int fq) const {
        #pragma unroll
        for (int ai = 0; ai < 2; ++ai)
        #pragma unroll
        for (int m = 0; m < 4; ++m) { const int rl = ai * 128 + wr * 64 + m * 16 + fr; const int row = u.pm * 256 + rl; (void)rl; (void)row;
            int b, t, kk; tok_tile(row, b, t, kk);
#pragma unroll
            for (int bj = 0; bj < 2; ++bj) { const int col = u.pn * 256 + bj * 128 + wc * 32 + 8 * fq; const int h = col >> 7, isv = (col >> 6) & 1, d8 = (col & 63) >> 3;
                const size_t tile = (size_t)((b * 4 + h) * NTILE + t);
                unsigned char* dst = isv ? (MV + tile * VB + vtile_off(kk, d8)) : (MK + tile * MKB + ktile_off(kk, d8));
                *(u32x4*)dst = pack8(acc[ai][bj][m][0], acc[ai][bj][m][1], 1.f); }
        }
    }
};

struct EpiOut {
    static __host__ __device__ __forceinline__ int perm(int r) { return pg8::perm32(r); }
    const float* res_lat; const float* res_ctx; float* x_lat; float* x_ctx; const float* g1;
    __device__ __forceinline__ void operator()(const f32x4 (&acc)[2][2][4][2], const pg8::Unit& u, int wr, int wc, int fr, int fq) const {
        const bool latent = u.pm < 128;
        const int bb = latent ? (u.pm >> 5) : 4;
        const float* rbase = latent ? res_lat : res_ctx - (size_t)NLAT * D;
        float* xbase = latent ? x_lat : x_ctx - (size_t)NLAT * D;
        const int c0 = u.pn * 256 + wc * 32 + 8 * fq;
        f32x4 gv[2][2];
#pragma unroll
        for (int bj = 0; bj < 2; ++bj)
#pragma unroll
            for (int n = 0; n < 2; ++n) gv[bj][n] = *(const f32x4*)(g1 + bb * 6144 + c0 + bj * 128 + 4 * n);
        #pragma unroll
        for (int ai = 0; ai < 2; ++ai)
        #pragma unroll
        for (int m = 0; m < 4; ++m) { const int rl = ai * 128 + wr * 64 + m * 16 + fr; const int row = u.pm * 256 + rl; (void)rl; (void)row;
#pragma unroll
            for (int bj = 0; bj < 2; ++bj)
#pragma unroll
                for (int n = 0; n < 2; ++n) { const size_t off = (size_t)row * D + c0 + bj * 128 + 4 * n;
                    const f32x4 r = *(const f32x4*)(rbase + off); *(f32x4*)(xbase + off) = r + gv[bj][n] * acc[ai][bj][m][n]; }
        }
    }
};

struct EpiMoe1 {
    static __host__ __device__ __forceinline__ int perm(int r) { return pg8::perm32(r); }
    bf16_t* H1;
    __device__ __forceinline__ void operator()(const f32x4 (&acc)[2][2][4][2], const pg8::Unit& u, int wr, int wc, int fr, int fq) const {
        #pragma unroll
        for (int ai = 0; ai < 2; ++ai)
        #pragma unroll
        for (int m = 0; m < 4; ++m) { const int rl = ai * 128 + wr * 64 + m * 16 + fr; const int row = u.pm * 256 + rl; (void)rl; (void)row;
            f32x4 h0; f32x4 h1;
#pragma unroll
            for (int e = 0; e < 4; ++e) { h0[e] = silu_f(acc[ai][0][m][0][e]) * acc[ai][1][m][0][e]; h1[e] = silu_f(acc[ai][0][m][1][e]) * acc[ai][1][m][1][e]; }
            *(u32x4*)(H1 + (size_t)row * DE + (u.pn & 3) * 128 + wc * 32 + 8 * fq) = pack8(h0, h1, 1.f);
        }
    }
};
struct EpiMoe2 {
    static __host__ __device__ __forceinline__ int perm(int r) { return pg8::perm32(r); }
    bf16_t* Y;
    __device__ __forceinline__ void operator()(const f32x4 (&acc)[2][2][4][2], const pg8::Unit& u, int wr, int wc, int fr, int fq) const {
        #pragma unroll
        for (int ai = 0; ai < 2; ++ai)
        #pragma unroll
        for (int m = 0; m < 4; ++m) { const int rl = ai * 128 + wr * 64 + m * 16 + fr; const int row = u.pm * 256 + rl; (void)rl; (void)row;
            bf16_t* rowp = Y + (size_t)row * D + (u.pn & 3) * 256 + wc * 32 + 8 * fq;
#pragma unroll
            for (int bj = 0; bj < 2; ++bj) *(u32x4*)(rowp + bj * 128) = pack8(acc[ai][bj][m][0], acc[ai][bj][m][1], 1.f);
        }
    }
};

struct MoeOrder {
    const LAS int* tb; int G, c;
    __device__ __forceinline__ bool next(int i, pg8::Unit& u) const {
        const int L = i * G + c; const int ntl = tb[32];
        if (L >= ntl * 4) return false;
        const int rt = L >> 2; int e = 0;
        for (int j = 1; j < 32; ++j) e += (tb[j] <= rt) ? 1 : 0;
        u.pm = rt; u.pn = e * 4 + (L & 3); u.aux = e; return true;
    }
};
struct MoeRows1 {
    static constexpr bool GATHER = true;
    int lda2; const LAS int* tb; const LAS int* cn; const int* list;
    __device__ __forceinline__ unsigned tok(const pg8::Unit& u, int lr) const {
        const int e = u.aux; int j = (u.pm - tb[e]) * 256 + lr; const int c = cn[e]; j = j < c ? j : c - 1;
        return (unsigned)(list[(size_t)e * MT + j] >> 1);
    }
};
__device__ __forceinline__ s16x4 vtr(const LAS unsigned char* p) { typedef short v4i16_t __attribute__((ext_vector_type(4))); return __builtin_bit_cast(s16x4, __builtin_amdgcn_ds_read_tr16_b64_v4i16((LAS v4i16_t*)p)); }

struct NaInfo { int active_lo, active_hi;
                int qrow, qcol, c0; const LAS float* tab; };

template <int KS, bool ISNA, bool ROPEQ>
__device__ __forceinline__ void attn_unit(LAS unsigned char* lds, const int tid, const bf16_t* Qw  , int qpitch,
                                          const unsigned char* Kt, const unsigned char* Vt, int a0, int na, int nb, bf16_t* Ow, const NaInfo& ni, const float* rope_row  ) {
    constexpr int KB = KS * 2048, TB = KB + 8192, NPK = KB / 1024, NP = NPK + 8;
    const int lane = tid & 63, r32 = lane & 31, hi = lane >> 5; const int wid = __builtin_amdgcn_readfirstlane(tid >> 6);
    const int NT = na + nb;
#define TIX(i) ((i) < na ? a0 + (i) : 128 + (i) - na)
#define ISSUE(i, b) do { const int tx_ = TIX(i); _Pragma("unroll") for (int pp = 0; pp < 3; ++pp) { const int p_ = wid + 8 * pp; if (p_ < NP) { \
        const unsigned char* src_ = (p_ < NPK) ? (Kt + (size_t)tx_ * KB + p_ * 1024) : (Vt + (size_t)tx_ * VB + (p_ - NPK) * 1024); \
        __builtin_amdgcn_global_load_lds((const unsigned*)(src_ + lane * 16), (LAS unsigned*)(lds + (b) * TB + p_ * 1024), 16, 0, 0); } } } while (0)
    ISSUE(0, 0);
    bf16x8 qf[KS];
#pragma unroll
    for (int s = 0; s < KS; ++s) qf[s] = *(const bf16x8*)(Qw + (size_t)r32 * qpitch + s * 16 + hi * 8);
    if constexpr (ROPEQ) {
        static_assert(KS == 6, "rope only on the MLA query");
        const float* rt = rope_row + (size_t)r32 * 32;
        const float sg = hi ? 1.f : -1.f;
#pragma unroll
        for (int s = 4; s < 6; ++s) {
            u32x4 w = __builtin_bit_cast(u32x4, qf[s]); u32x4 pw; u32x4 ow;
#pragma unroll
            for (int e = 0; e < 4; ++e) pw[e] = shxu(w[e], 32, lane);
#pragma unroll
            for (int e = 0; e < 4; ++e) { const f32x4 cs = *(const f32x4*)(rt + (s - 4) * 16 + 4 * e);
                const float lo = bf_lo(w[e]) * cs[0] + sg * bf_lo(pw[e]) * cs[1], hh = bf_hi(w[e]) * cs[2] + sg * bf_hi(pw[e]) * cs[3];
                ow[e] = pk2(lo, hh); }
            qf[s] = __builtin_bit_cast(bf16x8, ow);
        }
    }
    f32x16 o0 = {}, o1 = {};
    float mrun = -1e30f, lrun = 0.f;
    asm volatile("s_waitcnt vmcnt(0)" ::: "memory");
    __syncthreads();
    for (int i = 0; i < NT; ++i) {
        const int b = i & 1;
        if (i + 1 < NT) ISSUE(i + 1, b ^ 1);
        bool active = true; int dr = 0;
        if (ISNA && i < na) { const int krow = a0 + i; active = (krow >= ni.active_lo) && (krow <= ni.active_hi); dr = krow - ni.qrow + 7; }
        if (active) {
            const LAS unsigned char* kb = lds + b * TB + hi * 1024 + r32 * 16;
            f32x16 p0 = {}, p1 = {};
#pragma unroll
            for (int s = 0; s < KS; ++s) {
                const bf16x8 k0 = *(const LAS bf16x8*)(kb + s * 2048);
                const bf16x8 k1 = *(const LAS bf16x8*)(kb + s * 2048 + 512);
                p0 = __builtin_amdgcn_mfma_f32_32x32x16_bf16(k0, qf[s], p0, 0, 0, 0);
                p1 = __builtin_amdgcn_mfma_f32_32x32x16_bf16(k1, qf[s], p1, 0, 0, 0);
            }
            if (ISNA && i < na) {
                const LAS float* trow = ni.tab + dr * 31;
#pragma unroll
                for (int r = 0; r < 16; ++r) {
                    const int kc0 = crow(r, hi), kc1 = kc0 + 32;
                    int i0 = kc0 - ni.qcol + 15; i0 = i0 < 0 ? 0 : (i0 > 30 ? 30 : i0);
                    int i1 = kc1 - ni.qcol + 15; i1 = i1 < 0 ? 0 : (i1 > 30 ? 30 : i1);
                    const float b0 = trow[i0], b1 = trow[i1];
                    p0[r] = ((unsigned)(kc0 - ni.c0) < 16u) ? p0[r] + b0 : -1e30f;
                    p1[r] = ((unsigned)(kc1 - ni.c0) < 16u) ? p1[r] + b1 : -1e30f;
                }
            }
            float mx = fmaxf(p0[0], p1[0]);
#pragma unroll
            for (int r = 1; r < 16; ++r) mx = fmaxf(mx, fmaxf(p0[r], p1[r]));
            mx = fmaxf(mx, shx(mx, 32, lane));
            const float mnew = fmaxf(mrun, mx);
            const float alpha = __builtin_amdgcn_exp2f(mrun - mnew);
            mrun = mnew;
            float ps = 0.f;
#pragma unroll
            for (int r = 0; r < 16; ++r) { p0[r] = __builtin_amdgcn_exp2f(p0[r] - mnew); p1[r] = __builtin_amdgcn_exp2f(p1[r] - mnew); ps += p0[r] + p1[r]; }
            lrun = lrun * alpha + ps;
#pragma unroll
            for (int r = 0; r < 16; ++r) { o0[r] *= alpha; o1[r] *= alpha; }
            bf16x8 pf[4];
            { u32x4 w;
              w.x = pk2(p0[0], p0[1]); w.y = pk2(p0[2], p0[3]); w.z = pk2(p0[4], p0[5]); w.w = pk2(p0[6], p0[7]); pf[0] = __builtin_bit_cast(bf16x8, w);
              w.x = pk2(p0[8], p0[9]); w.y = pk2(p0[10], p0[11]); w.z = pk2(p0[12], p0[13]); w.w = pk2(p0[14], p0[15]); pf[1] = __builtin_bit_cast(bf16x8, w);
              w.x = pk2(p1[0], p1[1]); w.y = pk2(p1[2], p1[3]); w.z = pk2(p1[4], p1[5]); w.w = pk2(p1[6], p1[7]); pf[2] = __builtin_bit_cast(bf16x8, w);
              w.x = pk2(p1[8], p1[9]); w.y = pk2(p1[10], p1[11]); w.z = pk2(p1[12], p1[13]); w.w = pk2(p1[14], p1[15]); pf[3] = __builtin_bit_cast(bf16x8, w); }
            const LAS unsigned char* vb = lds + b * TB + KB + ((lane >> 4) & 1) * 32 + (lane & 3) * 8 + (4 * hi + ((lane & 15) >> 2)) * 64;
#pragma unroll
            for (int ks = 0; ks < 4; ++ks) {
                const s16x4 a0l = vtr(vb + ks * 1024), a0h = vtr(vb + ks * 1024 + 512);
                const s16x4 a1l = vtr(vb + 4096 + ks * 1024), a1h = vtr(vb + 4096 + ks * 1024 + 512);
                const bf16x8 va0 = {a0l[0], a0l[1], a0l[2], a0l[3], a0h[0], a0h[1], a0h[2], a0h[3]};
                const bf16x8 va1 = {a1l[0], a1l[1], a1l[2], a1l[3], a1h[0], a1h[1], a1h[2], a1h[3]};
                o0 = __builtin_amdgcn_mfma_f32_32x32x16_bf16(va0, pf[ks], o0, 0, 0, 0);
                o1 = __builtin_amdgcn_mfma_f32_32x32x16_bf16(va1, pf[ks], o1, 0, 0, 0);
            }
        }
        asm volatile("s_waitcnt vmcnt(0)" ::: "memory");
        __syncthreads();
    }
    const float ltot = lrun + shx(lrun, 32, lane);
    const float inv = 1.0f / ltot;
    bf16_t* orow = Ow + (size_t)r32 * D;
#pragma unroll
    for (int g = 0; g < 4; ++g) {
        u32x2 w0, w1;
        w0.x = pk2(o0[4 * g] * inv, o0[4 * g + 1] * inv); w0.y = pk2(o0[4 * g + 2] * inv, o0[4 * g + 3] * inv);
        w1.x = pk2(o1[4 * g] * inv, o1[4 * g + 1] * inv); w1.y = pk2(o1[4 * g + 2] * inv, o1[4 * g + 3] * inv);
        *(u32x2*)(orow + 8 * g + 4 * hi) = w0;
        *(u32x2*)(orow + 32 + 8 * g + 4 * hi) = w1;
    }
#undef TIX
#undef ISSUE
}
#define XB_TMO      128
#define XB_XCNT(j)  (256  + 64 * (j))
#define XB_XSUB(j)  (1280 + 64 * (j))
#define XB_XGEN(j)  (2304 + 64 * (j))
#define XB_TOP      3328
#define XB_TOPGEN   3392
#define XCD_BAR_WORDS 3456
#define XB_SPIN_CAP (1u << 18)
__device__ __forceinline__ unsigned xb_ld(unsigned* p)              { return __hip_atomic_load(p, __ATOMIC_RELAXED, __HIP_MEMORY_SCOPE_AGENT); }
__device__ __forceinline__ unsigned xb_add(unsigned* p, unsigned v) { return __hip_atomic_fetch_add(p, v, __ATOMIC_RELAXED, __HIP_MEMORY_SCOPE_AGENT); }
__device__ __forceinline__ unsigned xb_xcc_id() { return (unsigned)__builtin_amdgcn_s_getreg((3 << 11) | 20) & 0xFu; }
#define XB_SPIN(cond, bar) do { unsigned _sp = 0; while (cond) { __builtin_amdgcn_s_sleep(1); \
    if ((++_sp & 255u) == 0u) { if (xb_ld(&(bar)[XB_TMO])) break; if (_sp > XB_SPIN_CAP) { atomicAdd(&(bar)[XB_TMO], 1u); break; } } } } while (0)
struct XcdBarrier { unsigned* bar; unsigned x; volatile LAS unsigned* st; };
__device__ __forceinline__ XcdBarrier xcd_barrier_post(unsigned* bar, volatile LAS unsigned* st, int tid) {
    XcdBarrier b; b.bar = bar; b.x = xb_xcc_id(); b.st = st;
    if (tid == 0) (void)xb_add(&bar[XB_XCNT(b.x)], 1u);
    return b;
}
__device__ __forceinline__ void xcd_barrier_complete(unsigned* bar, unsigned x, unsigned& nloc, unsigned& nx) {
    const unsigned G = gridDim.x * gridDim.y * gridDim.z;
    unsigned sum, cnt, mine, sp = 0u;
    for (;;) {
        sum = 0u; cnt = 0u; mine = 0u;
#pragma unroll
        for (unsigned j = 0; j < 16; ++j) { const unsigned c = xb_ld(&bar[XB_XCNT(j)]); sum += c; cnt += (c > 0u) ? 1u : 0u; mine = (j == x) ? c : mine; }
        if (sum == G) break;
        __builtin_amdgcn_s_sleep(1);
        if ((++sp & 255u) == 0u) { if (xb_ld(&bar[XB_TMO])) break; if (sp > XB_SPIN_CAP) { atomicAdd(&bar[XB_TMO], 1u); break; } }
    }
    nloc = mine > 0u ? mine : 1u; nx = cnt > 0u ? cnt : 1u;
}
__device__ __forceinline__ void xcd_barrier(const XcdBarrier& b, int tid) {
    asm volatile("s_waitcnt vmcnt(0)" ::: "memory");
    __syncthreads();
    if (tid == 0) {
        unsigned* bar = b.bar;
        __builtin_amdgcn_s_waitcnt(0);
        unsigned nloc = b.st[0], nx = b.st[1];
        if (nloc == 0u) { xcd_barrier_complete(bar, b.x, nloc, nx); b.st[0] = nloc; b.st[1] = nx; }
        const unsigned old = xb_add(&bar[XB_XSUB(b.x)], 1u);
        const unsigned gen = old / nloc;
        if (old + 1u == (gen + 1u) * nloc) {
            __builtin_amdgcn_fence(__ATOMIC_RELEASE, "agent");
            asm volatile("s_waitcnt vmcnt(0)" ::: "memory");
            const unsigned og = xb_add(&bar[XB_TOP], 1u);
            const unsigned tg = og / nx;
            if (og + 1u == (tg + 1u) * nx) xb_add(&bar[XB_TOPGEN], 1u);
            else XB_SPIN(xb_ld(&bar[XB_TOPGEN]) == tg, bar);
            __builtin_amdgcn_fence(__ATOMIC_ACQUIRE, "agent");
            xb_add(&bar[XB_XGEN(b.x)], 1u);
            asm volatile("s_waitcnt vmcnt(0)" ::: "memory");
        } else {
            XB_SPIN(xb_ld(&bar[XB_XGEN(b.x)]) == gen, bar);
            __builtin_amdgcn_fence(__ATOMIC_ACQUIRE, "agent");
            asm volatile("s_waitcnt vmcnt(0)" ::: "memory");
        }
    }
    __syncthreads();
}

struct Args { const float* in[27]; float* out; unsigned char* ws; int l_lo, l_hi, ph_lo, ph_hi, flags, pad; };
enum { I_X = 0, I_C, I_CTX, I_CCTX, I_WADA, I_BADA, I_N1G, I_N2G, I_WIN, I_CONVW, I_SGW, I_SGB, I_RPB, I_QNG, I_WUQ, I_KVNG, I_WUKV, I_ONG, I_WOUT, I_WGRP, I_BGRP, I_WEXP, I_BEXP, I_WGATE, I_WUP, I_WDOWN, I_FNG };

struct Frame {
    LAS unsigned char* lds; unsigned char* ws; float* out;
    int tid, lane, wave, G, vcu, gw, NGW, bx, wave0;
};

__device__ __forceinline__ void transpose_item(const float* W, int ldw, int K, bf16_t* WT, int k0, int n0, int drow, LAS float* scr, int lane) {
#pragma unroll 8
    for (int i = 0; i < 32; ++i) { const int kk = 2 * i + (lane >> 5); scr[kk * 33 + (lane & 31)] = W[(size_t)(k0 + kk) * ldw + n0 + (lane & 31)]; }
    asm volatile("s_waitcnt lgkmcnt(0)" ::: "memory");
    const int c = lane & 7;
#pragma unroll
    for (int j = 0; j < 4; ++j) { const int n = (lane >> 3) + 8 * j; const LAS float* s = scr + (8 * c) * 33 + n;
        u32x4 o; o.x = pk2(s[0 * 33], s[1 * 33]); o.y = pk2(s[2 * 33], s[3 * 33]); o.z = pk2(s[4 * 33], s[5 * 33]); o.w = pk2(s[6 * 33], s[7 * 33]);
        *(u32x4*)(WT + (size_t)(drow + n) * K + k0 + 8 * c) = o; }
    asm volatile("s_waitcnt lgkmcnt(0)" ::: "memory");
}

__device__ __forceinline__ void phase_prologue(Frame& F, const Args& A) {
    LAS float* scr = (LAS float*)(F.lds + F.wave * 8448);
    unsigned char* ws = F.ws;
    constexpr int IT_IN = 16 * 77, IT_OUT = 16 * 32, IT_UQ = 4 * 12, IT_UKV = 2 * 16, IT_G = 16 * 16, IT_D = 8 * 32;
    constexpr int IT_LAYER = IT_IN + IT_OUT + IT_UQ + IT_UKV + NE * (2 * IT_G + IT_D);
    for (int it = F.gw; it < NL * IT_LAYER; it += F.NGW) {
        const int l = it / IT_LAYER; int r = it % IT_LAYER;
        if (r < IT_IN) { const int kb = r / 77, nb = r % 77; transpose_item(A.in[I_WIN] + (size_t)l * D * ZC, ZC, D, (bf16_t*)(ws + WS_WIN) + (size_t)l * ZP * D, 64 * kb, 32 * nb, 32 * nb, scr, F.lane); continue; } r -= IT_IN;
        if (r < IT_OUT) { const int kb = r / 32, nb = r % 32; transpose_item(A.in[I_WOUT] + (size_t)l * D * D, D, D, (bf16_t*)(ws + WS_WOUT) + (size_t)l * D * D, 64 * kb, 32 * nb, 32 * nb, scr, F.lane); continue; } r -= IT_OUT;
        if (r < IT_UQ) { const int kb = r / 12, nb = r % 12; transpose_item(A.in[I_WUQ] + (size_t)l * 256 * 384, 384, 256, (bf16_t*)(ws + WS_WUQ) + (size_t)l * 512 * 256, 64 * kb, 32 * nb, 32 * nb, scr, F.lane); continue; } r -= IT_UQ;
        if (r < IT_UKV) { const int kb = r / 16, nb = r % 16; transpose_item(A.in[I_WUKV] + (size_t)l * 128 * 512, 512, 128, (bf16_t*)(ws + WS_WUKV) + (size_t)l * 512 * 128, 64 * kb, 32 * nb, 32 * nb, scr, F.lane); continue; } r -= IT_UKV;
        const int e = r / (2 * IT_G + IT_D); r %= (2 * IT_G + IT_D);
        const size_t le = (size_t)l * NE + e;
        if (r < 2 * IT_G) { const int up = r >= IT_G; if (up) r -= IT_G; const int kb = r / 16, nb = r % 16; const int n0 = 32 * nb;
            transpose_item(A.in[up ? I_WUP : I_WGATE] + le * D * DE, DE, D, (bf16_t*)(ws + WS_W1) + le * 1024 * 1024, 64 * kb, n0, (n0 >> 7) * 256 + (n0 & 127) + (up ? 128 : 0), scr, F.lane); continue; }
        r -= 2 * IT_G;
        { const int kb = r / 32, nb = r % 32; transpose_item(A.in[I_WDOWN] + le * DE * D, D, DE, (bf16_t*)(ws + WS_W2) + le * 1024 * 512, 64 * kb, 32 * nb, 32 * nb, scr, F.lane); }
    }
    { const int gt = F.gw * 64 + F.lane, NGT = F.NGW * 64;
      constexpr int ZW = 96 * 1024 * 2 / 16, ZQ = 128 * 256 * 2 / 16;
      for (int i = gt; i < NL * (ZW + ZQ); i += NGT) { const int l = i / (ZW + ZQ), r = i % (ZW + ZQ);
          u32x4* p = r < ZW ? (u32x4*)(ws + WS_WIN + ((size_t)l * ZP + ZC) * D * 2) + r : (u32x4*)(ws + WS_WUQ + ((size_t)l * 512 + 384) * 256 * 2) + (r - ZW);
          *p = (u32x4){0u, 0u, 0u, 0u}; }
      for (int i = gt; i < NL * 4 * 128 * 16; i += NGT) { const int ch = i & 15, row = i >> 4; const int s = ch >> 1, hi = ch & 1;
          const float* src = A.in[I_SGW] + (size_t)row * 128 + 16 * s + 4 * hi;
          u32x4 o; o.x = pk2(src[0], src[1]); o.y = pk2(src[2], src[3]); o.z = pk2(src[8], src[9]); o.w = pk2(src[10], src[11]);
          *((u32x4*)(ws + WS_SGW) + i) = o; }
      for (int i = gt; i < SEQ * 16; i += NGT) { const int t = i >> 4, p = i & 15;
          const float pos = (p < 8) ? (float)(t >> 6) : (float)(t & 63);
          const float ang = pos * powf(10000.f, -(float)(p & 7) / 8.f);
          ((f32x2*)(ws + WS_ROPE))[i] = (f32x2){cosf(ang), sinf(ang)}; }
      for (int i = gt; i < NL * 36 * 1024; i += NGT) { const int k = i & 1023, j = (i >> 10) % 36, l = i / (36 * 1024);
          ((float*)(ws + WS_RW))[i] = j < 4 ? A.in[I_WGRP][((size_t)l * D + k) * 4 + j] : A.in[I_WEXP][((size_t)l * D + k) * 32 + (j - 4)]; }
    }
    __syncthreads();
    { LAS float* red = (LAS float*)(F.lds + 8 * 8448);
      for (int it = F.vcu; it < NL * 96; it += F.G) { const int l = it / 96, col = (it % 96) * 64 + F.lane;
          const float* w = A.in[I_WADA] + (size_t)l * D * 6144 + col;
          float a0 = 0.f, a1 = 0.f, a2 = 0.f, a3 = 0.f, a4 = 0.f;
          const int kb = F.wave * 128;
#pragma unroll 16
          for (int k = 0; k < 128; ++k) { const float wv = w[(size_t)(kb + k) * 6144];
              a0 += silu_f(A.in[I_C][kb + k]) * wv; a1 += silu_f(A.in[I_C][D + kb + k]) * wv; a2 += silu_f(A.in[I_C][2 * D + kb + k]) * wv; a3 += silu_f(A.in[I_C][3 * D + kb + k]) * wv; a4 += silu_f(A.in[I_CCTX][kb + k]) * wv; }
          red[(F.wave * 5 + 0) * 64 + F.lane] = a0; red[(F.wave * 5 + 1) * 64 + F.lane] = a1; red[(F.wave * 5 + 2) * 64 + F.lane] = a2; red[(F.wave * 5 + 3) * 64 + F.lane] = a3; red[(F.wave * 5 + 4) * 64 + F.lane] = a4;
          __syncthreads();
          if (F.tid < 320) { const int bb = F.tid >> 6, ln = F.tid & 63; float s = 0.f;
#pragma unroll
              for (int wv = 0; wv < 8; ++wv) s += red[(wv * 5 + bb) * 64 + ln];
              const int cc = (it % 96) * 64 + ln;
              ((float*)(ws + WS_MOD))[((size_t)l * 5 + bb) * 6144 + cc] = s + A.in[I_BADA][l * 6144 + cc]; }
          __syncthreads(); }
    }
}

__device__ __forceinline__ void moe_tables(Frame& F, const Args& A, int l) {
    LAS int* tb = (LAS int*)(F.lds + LDS_MOE); LAS int* cn = tb + 64;
    __syncthreads();
    if (F.tid == 0) { const int* cnt = (const int*)(F.ws + WS_CTL) + CW_CNT + l * NE; int acc = 0;
        for (int e = 0; e < NE; ++e) { const int c = __hip_atomic_load(cnt + e, __ATOMIC_RELAXED, __HIP_MEMORY_SCOPE_AGENT); tb[e] = acc; cn[e] = c; acc += (c + 255) >> 8; }
        tb[32] = acc; }
    __syncthreads();
}

__device__ __forceinline__ void load_x_row(Frame& F, const Args& A, int r, int l, int lp, f32x4 (&x)[4], bool write_back) {
    const float* xr;
    if (l == 0 && lp < 0) xr = r < NLAT ? A.in[I_X] + (size_t)r * D : A.in[I_CTX] + (size_t)(r - NLAT) * D;
    else xr = r < NLAT ? F.out + (size_t)r * D : (const float*)(F.ws + WS_XC) + (size_t)(r - NLAT) * D;
#pragma unroll
    for (int i = 0; i < 4; ++i) x[i] = *(const f32x4*)(xr + 4 * F.lane + 256 * i);
    if (lp >= 0) {
        const LAS int* tb = (const LAS int*)(F.lds + LDS_MOE);
        const int* asg = (const int*)(F.ws + WS_ASG); const float* gate = (const float*)(F.ws + WS_GATE);
        const int e0 = asg[4 * r], p0 = asg[4 * r + 1], e1 = asg[4 * r + 2], p1 = asg[4 * r + 3];
        const float g0 = gate[2 * r], g1 = gate[2 * r + 1];
        const bf16_t* y0 = (const bf16_t*)(F.ws + WS_Y) + (size_t)(tb[e0] * 256 + p0) * D; const bf16_t* y1 = (const bf16_t*)(F.ws + WS_Y) + (size_t)(tb[e1] * 256 + p1) * D;
        const float* g2 = (const float*)(F.ws + WS_MOD) + ((size_t)lp * 5 + mod_idx(r)) * 6144 + 5120;
        float* xw = r < NLAT ? F.out + (size_t)r * D : (float*)(F.ws + WS_XC) + (size_t)(r - NLAT) * D;
#pragma unroll
        for (int i = 0; i < 4; ++i) { const int c = 4 * F.lane + 256 * i;
            const u32x2 a = *(const u32x2*)(y0 + c), b = *(const u32x2*)(y1 + c); const f32x4 gg = *(const f32x4*)(g2 + c);
            x[i][0] += gg[0] * (g0 * bf_lo(a.x) + g1 * bf_lo(b.x)); x[i][1] += gg[1] * (g0 * bf_hi(a.x) + g1 * bf_hi(b.x));
            x[i][2] += gg[2] * (g0 * bf_lo(a.y) + g1 * bf_lo(b.y)); x[i][3] += gg[3] * (g0 * bf_hi(a.y) + g1 * bf_hi(b.y));
            if (write_back) *(f32x4*)(xw + c) = x[i]; }
    }
}
__device__ __forceinline__ float row_rs(const f32x4 (&x)[4], int lane) {
    float ss = 0.f;
#pragma unroll
    for (int i = 0; i < 4; ++i) ss += (x[i][0] * x[i][0] + x[i][1] * x[i][1]) + (x[i][2] * x[i][2] + x[i][3] * x[i][3]);
    return 1.0f / sqrtf(wave_sum(ss, lane) * (1.f / D) + EPS);
}

__device__ __forceinline__ void phase_norm1(Frame& F, const Args& A, int l) {
    if (l > 0) moe_tables(F, A, l - 1);
    const float* g = A.in[I_N1G] + l * D;
    for (int r = F.gw; r < MT; r += F.NGW) {
        f32x4 x[4]; load_x_row(F, A, r, l, l - 1, x, true);
        const float rs = row_rs(x, F.lane);
        const float* m = (const float*)(F.ws + WS_MOD) + ((size_t)l * 5 + mod_idx(r)) * 6144;
        bf16_t* h = (bf16_t*)(F.ws + WS_HB) + (size_t)r * D;
#pragma unroll
        for (int i = 0; i < 4; ++i) { const int c = 4 * F.lane + 256 * i; const f32x4 gv = *(const f32x4*)(g + c), sc = *(const f32x4*)(m + 1024 + c), sh = *(const f32x4*)(m + c);
            const f32x4 o = x[i] * rs * gv * (sc + 1.f) + sh; u32x2 w; w.x = pk2(o[0], o[1]); w.y = pk2(o[2], o[3]); *(u32x2*)(h + c) = w; }
    }
}
__device__ __forceinline__ void phase_final(Frame& F, const Args& A) {
    moe_tables(F, A, NL - 1);
    const float* g = A.in[I_FNG];
    for (int r = F.gw; r < NLAT; r += F.NGW) {
        f32x4 x[4]; load_x_row(F, A, r, NL, NL - 1, x, false);
        const float rs = row_rs(x, F.lane);
        float* o = F.out + (size_t)r * D;
#pragma unroll
        for (int i = 0; i < 4; ++i) { const int c = 4 * F.lane + 256 * i; *(f32x4*)(o + c) = x[i] * rs * *(const f32x4*)(g + c); }
    }
}

__device__ __forceinline__ void phase_conv(Frame& F, const Args& A, int l) {
    const bf16_t* Z = (const bf16_t*)(F.ws + WS_Z); bf16_t* YC = (bf16_t*)(F.ws + WS_YC);
    const float* cw = A.in[I_CONVW] + l * 768;
    for (int it = F.vcu * 512 + F.tid; it < MT * 32; it += F.G * 512) {
        const int r = it >> 5, cg = (it & 31) * 8;
        int t, n; if (r < NLAT) { t = r & 8191; n = SEQ; } else { t = (r - NLAT) & 255; n = CTX; }
        float acc[8] = {0.f, 0.f, 0.f, 0.f, 0.f, 0.f, 0.f, 0.f};
#pragma unroll
        for (int k = 0; k < 3; ++k) { const int tt = t + k - 1;
            if (tt >= 0 && tt < n) { const bf16_t* z = Z + (size_t)(r + k - 1) * ZP; const u32x4 c = *(const u32x4*)(z + 256 + cg), hx = *(const u32x4*)(z + 512 + cg);
                const f32x4 w0 = *(const f32x4*)(cw + k * 256 + cg), w1 = *(const f32x4*)(cw + k * 256 + cg + 4);
                acc[0] += bf_lo(c.x) * bf_lo(hx.x) * w0[0]; acc[1] += bf_hi(c.x) * bf_hi(hx.x) * w0[1]; acc[2] += bf_lo(c.y) * bf_lo(hx.y) * w0[2]; acc[3] += bf_hi(c.y) * bf_hi(hx.y) * w0[3];
                acc[4] += bf_lo(c.z) * bf_lo(hx.z) * w1[0]; acc[5] += bf_hi(c.z) * bf_hi(hx.z) * w1[1]; acc[6] += bf_lo(c.w) * bf_lo(hx.w) * w1[2]; acc[7] += bf_hi(c.w) * bf_hi(hx.w) * w1[3]; } }
        const u32x4 bg = *(const u32x4*)(Z + (size_t)r * ZP + cg);
        u32x4 o; o.x = pk2(bf_lo(bg.x) * acc[0], bf_hi(bg.x) * acc[1]); o.y = pk2(bf_lo(bg.y) * acc[2], bf_hi(bg.y) * acc[3]); o.z = pk2(bf_lo(bg.z) * acc[4], bf_hi(bg.z) * acc[5]); o.w = pk2(bf_lo(bg.w) * acc[6], bf_hi(bg.w) * acc[7]);
        *(u32x4*)(YC + (size_t)r * D + cg) = o;
    }
}

__device__ __forceinline__ void phase_sg(Frame& F, const Args& A, int l) {
    const bf16_t* Z = (const bf16_t*)(F.ws + WS_Z); bf16_t* YC = (bf16_t*)(F.ws + WS_YC);
    LAS unsigned char* vt = F.lds;
    LAS float* red = (LAS float*)(F.lds + 65536);
    const int lane = F.lane, r32 = lane & 31, hi = lane >> 5, w = F.wave, h = w >> 1, pb = w & 1;
    for (int ch = F.vcu; ch < MT / 128; ch += F.G) {
        const int r0 = ch * 128;
        { const int tok = F.tid & 127, hq = F.tid >> 7;
          const bf16_t* zv = Z + (size_t)(r0 + tok) * ZP + 1024 + hq * 64;
          float f[64]; float s1 = 0.f;
#pragma unroll
          for (int c8 = 0; c8 < 8; ++c8) { const u32x4 v = *(const u32x4*)(zv + 8 * c8);
              f[8 * c8 + 0] = gelu_tanh(bf_lo(v.x)); f[8 * c8 + 1] = gelu_tanh(bf_hi(v.x)); f[8 * c8 + 2] = gelu_tanh(bf_lo(v.y)); f[8 * c8 + 3] = gelu_tanh(bf_hi(v.y));
              f[8 * c8 + 4] = gelu_tanh(bf_lo(v.z)); f[8 * c8 + 5] = gelu_tanh(bf_hi(v.z)); f[8 * c8 + 6] = gelu_tanh(bf_lo(v.w)); f[8 * c8 + 7] = gelu_tanh(bf_hi(v.w)); }
#pragma unroll
          for (int j = 0; j < 64; ++j) s1 += f[j];
          red[hq * 128 + tok] = s1;
          __syncthreads();
          const float mean = (red[tok] + red[128 + tok] + red[256 + tok] + red[384 + tok]) * (1.f / 256.f);
          float s2 = 0.f;
#pragma unroll
          for (int j = 0; j < 64; ++j) { f[j] -= mean; s2 += f[j] * f[j]; }
          __syncthreads();
          red[hq * 128 + tok] = s2;
          __syncthreads();
          const float rstd = 1.0f / sqrtf((red[tok] + red[128 + tok] + red[256 + tok] + red[384 + tok]) * (1.f / 256.f) + EPS);
          LAS unsigned char* tile = vt + (hq * 2 + (tok >> 6)) * 8192;
#pragma unroll
          for (int d8 = 0; d8 < 8; ++d8) { u32x4 o; o.x = pk2(f[8 * d8] * rstd, f[8 * d8 + 1] * rstd); o.y = pk2(f[8 * d8 + 2] * rstd, f[8 * d8 + 3] * rstd); o.z = pk2(f[8 * d8 + 4] * rstd, f[8 * d8 + 5] * rstd); o.w = pk2(f[8 * d8 + 6] * rstd, f[8 * d8 + 7] * rstd);
              *(LAS u32x4*)(tile + vtile_off(tok & 63, d8)) = o; }
        }
        bf16x8 bfr[2][8];
#pragma unroll
        for (int pn = 0; pn < 2; ++pn)
#pragma unroll
            for (int s = 0; s < 8; ++s) bfr[pn][s] = *(const bf16x8*)(F.ws + WS_SGW + ((((size_t)(l * 4 + h) * 128 + 64 * pb + 32 * pn + r32) * 8 + s) * 2 + hi) * 16);
        __syncthreads();
        f32x16 acc[2][2] = {};
        const LAS unsigned char* vb = vt + h * 16384 + ((lane >> 4) & 1) * 32 + (lane & 3) * 8 + (4 * hi + ((lane & 15) >> 2)) * 64;
#pragma unroll
        for (int s = 0; s < 8; ++s) {
            const LAS unsigned char* p = vb + (s >> 2) * 8192 + (s & 3) * 1024;
            const s16x4 a0l = vtr(p), a0h = vtr(p + 512), a1l = vtr(p + 4096), a1h = vtr(p + 4096 + 512);
            const bf16x8 va0 = {a0l[0], a0l[1], a0l[2], a0l[3], a0h[0], a0h[1], a0h[2], a0h[3]};
            const bf16x8 va1 = {a1l[0], a1l[1], a1l[2], a1l[3], a1h[0], a1h[1], a1h[2], a1h[3]};
#pragma unroll
            for (int pn = 0; pn < 2; ++pn) { acc[0][pn] = __builtin_amdgcn_mfma_f32_32x32x16_bf16(va0, bfr[pn][s], acc[0][pn], 0, 0, 0); acc[1][pn] = __builtin_amdgcn_mfma_f32_32x32x16_bf16(va1, bfr[pn][s], acc[1][pn], 0, 0, 0); }
        }
#pragma unroll
        for (int pn = 0; pn < 2; ++pn) { const int p = 64 * pb + 32 * pn + r32; const int row = r0 + p;
            const float bias = A.in[I_SGB][(l * 4 + h) * 128 + p];
#pragma unroll
            for (int db = 0; db < 2; ++db)
#pragma unroll
                for (int g = 0; g < 4; ++g) { const int d = 32 * db + 8 * g + 4 * hi;
                    const u32x2 uz = *(const u32x2*)(Z + (size_t)row * ZP + 768 + h * 64 + d);
                    const float u0 = gelu_tanh(bf_lo(uz.x)), u1 = gelu_tanh(bf_hi(uz.x)), u2 = gelu_tanh(bf_lo(uz.y)), u3 = gelu_tanh(bf_hi(uz.y));
                    u32x2 o; o.x = pk2(u0 * (acc[db][pn][4 * g] + bias), u1 * (acc[db][pn][4 * g + 1] + bias)); o.y = pk2(u2 * (acc[db][pn][4 * g + 2] + bias), u3 * (acc[db][pn][4 * g + 3] + bias));
                    *(u32x2*)(YC + (size_t)row * D + 256 + h * 64 + d) = o; } }
        __syncthreads();
    }
}

__device__ __forceinline__ void phase_mlaprep(Frame& F, const Args& A, int l) {
    const bf16_t* Z = (const bf16_t*)(F.ws + WS_Z);
    const float* qg = A.in[I_QNG] + l * 256; const float* kg = A.in[I_KVNG] + l * 128;
    const int lane = F.lane;
    for (int r = F.gw; r < MT; r += F.NGW) {
        const bf16_t* z = Z + (size_t)r * ZP + 2048;
        const u32x2 a = *(const u32x2*)(z + 4 * lane);
        const float q0 = bf_lo(a.x), q1 = bf_hi(a.x), q2 = bf_lo(a.y), q3 = bf_hi(a.y);
        const float rsq = 1.0f / sqrtf(wave_sum((q0 * q0 + q1 * q1) + (q2 * q2 + q3 * q3), lane) * (1.f / 256.f) + EPS);
        const f32x4 gq = *(const f32x4*)(qg + 4 * lane);
        u32x2 oq; oq.x = pk2(q0 * rsq * gq[0], q1 * rsq * gq[1]); oq.y = pk2(q2 * rsq * gq[2], q3 * rsq * gq[3]);
        *(u32x2*)((bf16_t*)(F.ws + WS_CQN) + (size_t)r * 256 + 4 * lane) = oq;
        const unsigned kvw = *(const unsigned*)(z + 256 + 2 * lane);
        const float k0 = bf_lo(kvw), k1 = bf_hi(kvw);
        const float rsk = 1.0f / sqrtf(wave_sum(k0 * k0 + k1 * k1, lane) * (1.f / 128.f) + EPS);
        *(unsigned*)((bf16_t*)(F.ws + WS_CKVN) + (size_t)r * 128 + 2 * lane) = pk2(k0 * rsk * kg[2 * lane], k1 * rsk * kg[2 * lane + 1]);
        const int j = lane & 31;
        const float xv = bf1(z[384 + j]);
        const float pv = shx(xv, 8, lane);
        float o = xv;
        if (r < NLAT) { const int p = (j & 7) + ((j >> 4) << 3); const f32x2 cs = ((const f32x2*)(F.ws + WS_ROPE))[(size_t)(r & 8191) * 16 + p];
            o = (j & 8) ? (xv * cs.x + pv * cs.y) : (xv * cs.x - pv * cs.y); }
        int b, t, kk; tok_tile(r, b, t, kk);
        if (lane < 32) { const bf16_t ob = (bf16_t)f2bf(o);
#pragma unroll
            for (int hh = 0; hh < 4; ++hh) *(bf16_t*)(F.ws + WS_MK + (size_t)((b * 4 + hh) * NTILE + t) * MKB + ktile_off(kk, 8 + (j >> 3)) + (j & 7) * 2) = ob; }
    }
}

__device__ __forceinline__ void phase_mergenorm(Frame& F, const Args& A, int l) {
    bf16_t* YC = (bf16_t*)(F.ws + WS_YC); const float* og = A.in[I_ONG] + l * D;
    for (int r = F.gw; r < MT; r += F.NGW) {
        bf16_t* y = YC + (size_t)r * D;
#pragma unroll
        for (int i = 0; i < 4; ++i) { const int c = 4 * F.lane + 256 * i; const u32x2 a = *(const u32x2*)(y + c);
            const float v0 = bf_lo(a.x), v1 = bf_hi(a.x), v2 = bf_lo(a.y), v3 = bf_hi(a.y);
            const float rs = 1.0f / sqrtf(wave_sum((v0 * v0 + v1 * v1) + (v2 * v2 + v3 * v3), F.lane) * (1.f / 256.f) + EPS);
            const f32x4 g = *(const f32x4*)(og + c);
            u32x2 o; o.x = pk2(v0 * rs * g[0], v1 * rs * g[1]); o.y = pk2(v2 * rs * g[2], v3 * rs * g[3]); *(u32x2*)(y + c) = o; }
    }
}

__device__ __forceinline__ void phase_router(Frame& F, const Args& A, int l) {
    LAS float* rw = (LAS float*)F.lds;
    __syncthreads();
    { const f32x4* src = (const f32x4*)((const float*)(F.ws + WS_RW) + (size_t)l * 36 * 1024);
      for (int i = F.tid; i < 36 * 256; i += 512) ((LAS f32x4*)rw)[i] = src[i]; }
    __syncthreads();
    const int nrows = (l < NL - 1) ? MT : NLAT;
    const float* g = A.in[I_N2G] + l * D; const float* bgrp = A.in[I_BGRP] + l * 4; const float* bexp = A.in[I_BEXP] + l * NE;
    int* cnt = (int*)(F.ws + WS_CTL) + CW_CNT + l * NE; int* list = (int*)(F.ws + WS_LIST); int* asg = (int*)(F.ws + WS_ASG); float* gate = (float*)(F.ws + WS_GATE);
    for (int r = F.gw; r < nrows; r += F.NGW) {
        f32x4 x[4]; load_x_row(F, A, r, l + 1, -1, x, false);
        const float rs = row_rs(x, F.lane);
        const float* m = (const float*)(F.ws + WS_MOD) + ((size_t)l * 5 + mod_idx(r)) * 6144;
        bf16_t* hrow = (bf16_t*)(F.ws + WS_HB) + (size_t)r * D;
#pragma unroll
        for (int i = 0; i < 4; ++i) { const int c = 4 * F.lane + 256 * i; const f32x4 gv = *(const f32x4*)(g + c), sc = *(const f32x4*)(m + 4096 + c), sh = *(const f32x4*)(m + 3072 + c);
            x[i] = x[i] * rs * gv * (sc + 1.f) + sh; u32x2 w; w.x = pk2(x[i][0], x[i][1]); w.y = pk2(x[i][2], x[i][3]); *(u32x2*)(hrow + c) = w; }
        float lg[4];
#pragma unroll
        for (int j = 0; j < 4; ++j) { float a = 0.f;
#pragma unroll
            for (int i = 0; i < 4; ++i) { const f32x4 wv = *(const LAS f32x4*)(rw + j * 1024 + 4 * F.lane + 256 * i); a += (x[i][0] * wv[0] + x[i][1] * wv[1]) + (x[i][2] * wv[2] + x[i][3] * wv[3]); }
            lg[j] = wave_sum(a, F.lane) + bgrp[j]; }
        int gs = 0; float gm = lg[0];
#pragma unroll
        for (int j = 1; j < 4; ++j) if (lg[j] > gm) { gm = lg[j]; gs = j; }
        float se = 0.f;
#pragma unroll
        for (int j = 0; j < 4; ++j) se += __expf(lg[j] - gm);
        const float pg = 1.f / se;
        gs = __builtin_amdgcn_readfirstlane(gs);
        float el[8];
#pragma unroll
        for (int j = 0; j < 8; ++j) { float a = 0.f; const LAS float* wr_ = rw + (4 + gs * 8 + j) * 1024;
#pragma unroll
            for (int i = 0; i < 4; ++i) { const f32x4 wv = *(const LAS f32x4*)(wr_ + 4 * F.lane + 256 * i); a += (x[i][0] * wv[0] + x[i][1] * wv[1]) + (x[i][2] * wv[2] + x[i][3] * wv[3]); }
            el[j] = wave_sum(a, F.lane) + bexp[gs * 8 + j]; }
        int i1 = 0; float v1 = el[0];
#pragma unroll
        for (int j = 1; j < 8; ++j) if (el[j] > v1) { v1 = el[j]; i1 = j; }
        int i2 = 0; float v2 = -INFINITY;
#pragma unroll
        for (int j = 0; j < 8; ++j) if (j != i1 && el[j] > v2) { v2 = el[j]; i2 = j; }
        const float e2 = __expf(v2 - v1);
        const float w1 = 1.f / (1.f + e2), w2 = e2 / (1.f + e2);
        if (F.lane == 0) {
            const int E1 = gs * 8 + i1, E2 = gs * 8 + i2;
            const int p1 = atomicAdd(&cnt[E1], 1), p2 = atomicAdd(&cnt[E2], 1);
            list[(size_t)E1 * MT + p1] = r * 2; list[(size_t)E2 * MT + p2] = r * 2 + 1;
            asg[4 * r] = E1; asg[4 * r + 1] = p1; asg[4 * r + 2] = E2; asg[4 * r + 3] = p2;
            gate[2 * r] = pg * w1; gate[2 * r + 1] = pg * w2;
        }
    }
}
__device__ __forceinline__ void phase_attn(Frame& F, const Args& A, int l) {
    const unsigned char* ws = F.ws;
    const bf16_t* Z = (const bf16_t*)(ws + WS_Z); const bf16_t* QM = (const bf16_t*)(ws + WS_QM); bf16_t* YC = (bf16_t*)(F.ws + WS_YC);
    LAS float* tab = (LAS float*)(F.lds + 40960);
    const int w = F.wave;
    const int nctx = (l < NL - 1) ? 16 : 0;
    for (int k = F.vcu; k < 512 + nctx; k += F.G) {
        const int uid = (F.G == 256 && k < 512) ? ((k & 255) * 2 + (k >> 8)) : k;
        NaInfo ni; ni.active_lo = 0; ni.active_hi = -1; ni.qrow = 0; ni.qcol = 0; ni.c0 = 0; ni.tab = tab;
        if (uid < 512) {
            const int b = uid >> 7, h = (uid >> 5) & 3, R0 = (uid & 31) * 4;
            __syncthreads();
            if (F.tid < 465) tab[F.tid] = A.in[I_RPB][(size_t)(l * 4 + h) * 465 + F.tid] * LOG2E;
            const int qrow = R0 + (w >> 1), qcol = 32 * (w & 1) + (F.lane & 31);
            const int bs = min(max(qrow - 4, 0), 120);
            ni.active_lo = bs; ni.active_hi = bs + 7; ni.qrow = qrow; ni.qcol = qcol; ni.c0 = min(max(qcol - 8, 0), 48);
            const int U0 = min(max(R0 - 4, 0), 120), U1 = min(max(R0 + 3 - 4, 0), 120) + 7;
            const int q0 = b * SEQ + qrow * 64 + 32 * (w & 1);
            const size_t tb = (size_t)(b * 4 + h) * NTILE;
            attn_unit<4, true, false>(F.lds, F.tid, Z + (size_t)q0 * ZP + 1280 + h * 64, ZP, ws + WS_NK + tb * NKB, ws + WS_NV + tb * VB, U0, U1 - U0 + 1, 4, YC + (size_t)q0 * D + 512 + h * 64, ni, nullptr);
        } else {
            const int cu = uid - 512, b = cu >> 2, h = cu & 3;
            const int q0 = NLAT + b * CTX + 32 * w;
            const size_t tb = (size_t)(b * 4 + h) * NTILE;
            attn_unit<4, false, false>(F.lds, F.tid, Z + (size_t)q0 * ZP + 1280 + h * 64, ZP, ws + WS_NK + tb * NKB, ws + WS_NV + tb * VB, 128, 4, 0, YC + (size_t)q0 * D + 512 + h * 64, ni, nullptr);
        }
    }
    for (int k = F.vcu; k < 512 + nctx; k += F.G) {
        const int uid = (F.G == 256 && k < 512) ? ((k & 255) * 2 + (k >> 8)) : k;
        NaInfo ni; ni.active_lo = 0; ni.active_hi = -1; ni.qrow = 0; ni.qcol = 0; ni.c0 = 0; ni.tab = tab;
        if (uid < 512) {
            const int b = uid >> 7, h = (uid >> 5) & 3, qb = uid & 31;
            const int q0 = b * SEQ + qb * 256 + 32 * w;
            const size_t tb = (size_t)(b * 4 + h) * NTILE;
            attn_unit<6, false, true>(F.lds, F.tid, QM + (size_t)q0 * 384 + h * 96, 384, ws + WS_MK + tb * MKB, ws + WS_MV + tb * VB, 0, NTILE, 0, YC + (size_t)q0 * D + 768 + h * 64, ni, (const float*)(ws + WS_ROPE) + (size_t)(q0 & 8191) * 32);
        } else {
            const int cu = uid - 512, b = cu >> 2, h = cu & 3;
            const int q0 = NLAT + b * CTX + 32 * w;
            const size_t tb = (size_t)(b * 4 + h) * NTILE;
            attn_unit<6, false, false>(F.lds, F.tid, QM + (size_t)q0 * 384 + h * 96, 384, ws + WS_MK + tb * MKB, ws + WS_MV + tb * VB, 128, 4, 0, YC + (size_t)q0 * D + 768 + h * 64, ni, nullptr);
        }
    }
}

__device__ __forceinline__ void frame_ids(Frame& F) {
    { int t = (F.wave0 << 6) | lane_id(); asm volatile("" : "+v"(t)); F.tid = t; } F.lane = F.tid & 63; F.wave = __builtin_amdgcn_readfirstlane(F.tid >> 6);
    int bx = blockIdx.x; asm volatile("" : "+s"(bx));
    F.G = gridDim.x; F.vcu = (bx & 7) * (F.G >> 3) + (bx >> 3); F.bx = bx;
    F.gw = F.vcu * 8 + F.wave; F.NGW = F.G * 8;
}
__global__ void __launch_bounds__(512, 2) fwd(Args args) {
    extern __shared__ __attribute__((aligned(16))) unsigned char lds_raw[];
    Frame F;
    F.lds = (LAS unsigned char*)lds_raw; F.ws = args.ws; F.out = args.out;
    F.wave0 = __builtin_amdgcn_readfirstlane((int)threadIdx.x >> 6);
    frame_ids(F);
    volatile LAS unsigned* MISC = (volatile LAS unsigned*)(F.lds + LDS_MISC);
    if (F.tid < 64) MISC[F.tid] = 0u;
    __syncthreads();
    XcdBarrier bar; bar.bar = (unsigned*)(args.ws + WS_CTL) + CW_BAR; bar.x = 0; bar.st = nullptr;
    if (args.flags & 4) bar = xcd_barrier_post((unsigned*)(args.ws + WS_CTL) + CW_BAR, MISC + 8, F.tid);
#define GRID_BAR() do { if (args.flags & 4) xcd_barrier(bar, (F.wave0 << 6) | lane_id()); } while (0)
#ifndef PHASE_MASK
#define PHASE_MASK 0xFFFF
#endif
#define IN(k) (((PHASE_MASK >> (k)) & 1) && args.ph_lo <= (k) && (k) < args.ph_hi)
    if ((PHASE_MASK & 1) && (args.flags & 1)) { phase_prologue(F, args); GRID_BAR(); }
#define LAUNDER() GAS unsigned char* wsg_ = (GAS unsigned char*)args.ws; asm volatile("" : "+s"(wsg_)); unsigned char* ws = (unsigned char*)wsg_; int l = l_; asm volatile("" : "+s"(l)); F.ws = ws; frame_ids(F)
    for (int l_ = args.l_lo; l_ < args.l_hi; ++l_) {
        if (IN(1)) { LAUNDER(); phase_norm1(F, args, l); GRID_BAR(); }
        if (IN(2)) { LAUNDER();
            pg8::Gemm g{(const bf16_t*)(ws + WS_HB), (const bf16_t*)(ws + WS_WIN) + (size_t)l * ZP * D, D, D};
            pg8::StaticOrder S; S.init(MT, ZP, F.G, F.bx); pg8::PlainRows AR{D * 2};
            EpiZ E{(bf16_t*)(ws + WS_Z), ws + WS_NK, ws + WS_NV};
            pg8::gemm_phase<EpiZ, pg8::StaticOrder, pg8::PlainRows, true, true>(F.lds, F.tid, g, S, AR, E);
            GRID_BAR();
        }
        if (IN(3)) { LAUNDER(); phase_conv(F, args, l); __syncthreads(); frame_ids(F); phase_sg(F, args, l); __syncthreads(); frame_ids(F); phase_mlaprep(F, args, l); GRID_BAR(); }
        if (IN(4)) { LAUNDER();
            { pg8::Gemm g{(const bf16_t*)(ws + WS_CQN), (const bf16_t*)(ws + WS_WUQ) + (size_t)l * 512 * 256, 256, 256};
              pg8::StaticOrder S; S.init(MT, 512, F.G, F.bx); pg8::PlainRows AR{256 * 2};
              EpiQ E{(bf16_t*)(ws + WS_QM)};
              pg8::gemm_phase<EpiQ, pg8::StaticOrder, pg8::PlainRows, true, true>(F.lds, F.tid, g, S, AR, E); }
            frame_ids(F);
            { pg8::Gemm g{(const bf16_t*)(ws + WS_CKVN), (const bf16_t*)(ws + WS_WUKV) + (size_t)l * 512 * 128, 128, 128};
              pg8::StaticOrder S; S.init(MT, 512, F.G, (F.G - 1 - F.bx)); pg8::PlainRows AR{128 * 2};
              EpiKV E{ws + WS_MK, ws + WS_MV};
              pg8::gemm_phase<EpiKV, pg8::StaticOrder, pg8::PlainRows, true, true>(F.lds, F.tid, g, S, AR, E); }
            GRID_BAR();
        }
        if (IN(5)) { LAUNDER(); phase_attn(F, args, l); GRID_BAR(); }
        if (IN(6)) { LAUNDER(); phase_mergenorm(F, args, l); GRID_BAR(); }
        if (IN(7)) { LAUNDER();
            pg8::Gemm g{(const bf16_t*)(ws + WS_YC), (const bf16_t*)(ws + WS_WOUT) + (size_t)l * D * D, D, D};
            pg8::StaticOrder S; S.init(MT, D, F.G, F.bx); pg8::PlainRows AR{D * 2};
            EpiOut E{l == 0 ? args.in[I_X] : args.out, l == 0 ? args.in[I_CTX] : (const float*)(ws + WS_XC), args.out, (float*)(ws + WS_XC), (const float*)(ws + WS_MOD) + (size_t)l * 5 * 6144 + 2048};
            pg8::gemm_phase<EpiOut, pg8::StaticOrder, pg8::PlainRows, true, true>(F.lds, F.tid, g, S, AR, E);
            GRID_BAR();
        }
        if (IN(8)) { LAUNDER(); phase_router(F, args, l); GRID_BAR(); }
        if (IN(9)) { LAUNDER();
            moe_tables(F, args, l);
            const LAS int* tb = (const LAS int*)(F.lds + LDS_MOE);
            pg8::Gemm g{(const bf16_t*)(ws + WS_HB), (const bf16_t*)(ws + WS_W1) + (size_t)l * NE * 1024 * 1024, D, D};
            MoeOrder S{tb, F.G, F.bx}; MoeRows1 AR{D * 2, tb, tb + 64, (const int*)(ws + WS_LIST)};
            EpiMoe1 E{(bf16_t*)(ws + WS_H1)};
            pg8::gemm_phase<EpiMoe1, MoeOrder, MoeRows1, true, true>(F.lds, F.tid, g, S, AR, E);
            GRID_BAR();
        }
        if (IN(10)) { LAUNDER();
            moe_tables(F, args, l);
            const LAS int* tb = (const LAS int*)(F.lds + LDS_MOE);
            pg8::Gemm g{(const bf16_t*)(ws + WS_H1), (const bf16_t*)(ws + WS_W2) + (size_t)l * NE * 1024 * 512, DE, DE};
            MoeOrder S{tb, F.G, F.bx}; pg8::PlainRows AR{DE * 2};
            EpiMoe2 E{(bf16_t*)(ws + WS_Y)};
            pg8::gemm_phase<EpiMoe2, MoeOrder, pg8::PlainRows, true, true>(F.lds, F.tid, g, S, AR, E);
            GRID_BAR();
        }
    }
    if (((PHASE_MASK >> 11) & 1) && (args.flags & 2)) { frame_ids(F); phase_final(F, args); }
#undef IN
#undef GRID_BAR
}
}

#ifndef MK_ONE_LAUNCH
#define MK_ONE_LAUNCH 1
#endif
extern "C" void kernel_launch(void* const* d_in, const int* in_sizes, int n_in, void* d_out, int out_size, void* d_ws, size_t ws_size, hipStream_t stream) {
    using namespace mk;
    static int grid = 0;
    if (grid == 0) {
        if (n_in != 27 || ws_size < WS_END) { fprintf(stderr, "kernel_launch: unexpected inputs (n_in %d, ws %zu)\n", n_in, ws_size); grid = -1; return; }
        int dev = 0, cus = 0;
        if (hipGetDevice(&dev) != hipSuccess || hipDeviceGetAttribute(&cus, hipDeviceAttributeMultiprocessorCount, dev) != hipSuccess) { grid = -1; return; }
        if (hipFuncSetAttribute((const void*)fwd, hipFuncAttributeMaxDynamicSharedMemorySize, LDS_BYTES) != hipSuccess) { fprintf(stderr, "kernel_launch: hipFuncSetAttribute failed\n"); grid = -1; return; }
        int per_cu = 0;
        if (hipOccupancyMaxActiveBlocksPerMultiprocessor(&per_cu, (const void*)fwd, 512, LDS_BYTES) != hipSuccess || per_cu < 1) fprintf(stderr, "kernel_launch: occupancy query says %d\n", per_cu);
        (void)hipGetLastError();
        grid = cus & ~7;
    }
    if (grid < 0) return;
    if (hipMemsetAsync((char*)d_ws + WS_CTL, 0, CTL_BYTES, stream) != hipSuccess) return;
    Args a; memset(&a, 0, sizeof(a));
    for (int i = 0; i < 27; ++i) a.in[i] = (const float*)d_in[i];
    a.out = (float*)d_out; a.ws = (unsigned char*)d_ws;
#if MK_ONE_LAUNCH
    a.l_lo = 0; a.l_hi = NL; a.ph_lo = 1; a.ph_hi = 11; a.flags = 1 | 2 | 4;
    hipLaunchKernelGGL(fwd, dim3(grid), dim3(512), LDS_BYTES, stream, a);
#else
    a.l_lo = 0; a.l_hi = 0; a.ph_lo = 0; a.ph_hi = 0; a.flags = 1;
    hipLaunchKernelGGL(fwd, dim3(grid), dim3(512), LDS_BYTES, stream, a);
    for (int l = 0; l < NL; ++l)
        for (int ph = 1; ph <= 10; ++ph) { a.l_lo = l; a.l_hi = l + 1; a.ph_lo = ph; a.ph_hi = ph + 1; a.flags = 0; hipLaunchKernelGGL(fwd, dim3(grid), dim3(512), LDS_BYTES, stream, a); }
    a.l_lo = 0; a.l_hi = 0; a.ph_lo = 0; a.ph_hi = 0; a.flags = 2;
    hipLaunchKernelGGL(fwd, dim3(grid), dim3(512), LDS_BYTES, stream, a);
#endif
}
```

```cpp
#define MK_ONE_LAUNCH 1
#include <hip/hip_runtime.h>
#include <stdint.h>
#include <string.h>
#include <stdio.h>

#define LAS __attribute__((address_space(3)))
#define GAS __attribute__((address_space(1)))
typedef unsigned short bf16_t;
typedef short bf16x8 __attribute__((ext_vector_type(8)));
typedef short s16x4 __attribute__((ext_vector_type(4)));
typedef float f32x4 __attribute__((ext_vector_type(4)));
typedef float f32x2 __attribute__((ext_vector_type(2)));
typedef float f32x16 __attribute__((ext_vector_type(16)));
typedef unsigned u32x4 __attribute__((ext_vector_type(4)));
typedef unsigned u32x2 __attribute__((ext_vector_type(2)));
typedef __bf16 bf16x2_t __attribute__((ext_vector_type(2)));

namespace mk {
constexpr int D = 1024, NB = 4, SEQ = 8192, NL = 4, CTX = 256, NLAT = NB * SEQ, NCTX = NB * CTX, MT = NLAT + NCTX;
constexpr int ZC = 2464, ZP = 2560;
constexpr int NE = 32, DE = 512;
constexpr int NTILE = 132;
constexpr int SLOT_TILES = 296, SLOT_ROWS = SLOT_TILES * 256;
constexpr float EPS = 1e-6f;
constexpr float LOG2E = 1.4426950408889634f;
constexpr float MLA_QSCALE = 0.10206207261596577f * LOG2E;
constexpr float NA_QSCALE = 0.125f * LOG2E;
constexpr int MKB = 12288, NKB = 8192, VB = 8192;

constexpr size_t MiB = 1u << 20;
constexpr size_t WS_CTL = 0, CTL_BYTES = 1 * MiB;
constexpr size_t WS_MOD = 1 * MiB;
constexpr size_t WS_ROPE = 2 * MiB;
constexpr size_t WS_RW = 3 * MiB;
constexpr size_t WS_CONV = 4 * MiB;
constexpr size_t WS_WIN = 5 * MiB;
constexpr size_t WS_WOUT = 25 * MiB;
constexpr size_t WS_WUQ = 33 * MiB;
constexpr size_t WS_WUKV = 34 * MiB;
constexpr size_t WS_SGW = 35 * MiB;
constexpr size_t WS_W1 = 36 * MiB;
constexpr size_t WS_W2 = 292 * MiB;
constexpr size_t WS_XC = 420 * MiB;
constexpr size_t WS_HB = 424 * MiB;
constexpr size_t WS_Z = 490 * MiB;
constexpr size_t WS_YC = 655 * MiB;
constexpr size_t WS_H1 = WS_Z;
constexpr size_t WS_Y = WS_Z + 74 * MiB;
constexpr size_t WS_CQN = 721 * MiB;
constexpr size_t WS_CKVN = 738 * MiB;
constexpr size_t WS_QM = 747 * MiB;
constexpr size_t WS_MK = 772 * MiB;
constexpr size_t WS_MV = 797 * MiB;
constexpr size_t WS_NK = 814 * MiB;
constexpr size_t WS_NV = 831 * MiB;
constexpr size_t WS_LIST = 848 * MiB;
constexpr size_t WS_ASG = 853 * MiB;
constexpr size_t WS_GATE = 854 * MiB;
constexpr size_t WS_END = 855 * MiB;
static_assert(WS_H1 + (size_t)SLOT_ROWS * 512 * 2 <= WS_Y && WS_Y + (size_t)SLOT_ROWS * 1024 * 2 <= WS_CQN, "moe overlay");
static_assert(WS_Z + (size_t)MT * ZP * 2 <= WS_YC && WS_YC + (size_t)MT * D * 2 <= WS_CQN, "z/yc");
constexpr int CW_BAR = 4096;
constexpr int CW_CNT = 8192;
constexpr int LDS_SCRATCH = 147456;
constexpr int LDS_MOE = 131072;
constexpr int LDS_MISC = 147456;
constexpr int LDS_BYTES = 163840;

__device__ __forceinline__ unsigned f2bf(float f) { unsigned u = __builtin_bit_cast(unsigned, f); return (u + 0x7fffu + ((u >> 16) & 1u)) >> 16; }
__device__ __forceinline__ unsigned pk2(float lo, float hi) { f32x2 v = {lo, hi}; bf16x2_t b = __builtin_convertvector(v, bf16x2_t); return __builtin_bit_cast(unsigned, b); }
__device__ __forceinline__ float bf_lo(unsigned w) { return __builtin_bit_cast(float, w << 16); }
__device__ __forceinline__ float bf_hi(unsigned w) { return __builtin_bit_cast(float, w & 0xffff0000u); }
__device__ __forceinline__ float bf1(bf16_t h) { return __builtin_bit_cast(float, (unsigned)h << 16); }
__device__ __forceinline__ float shx(float v, int o, int lane) { return __builtin_bit_cast(float, __builtin_amdgcn_ds_bpermute((lane ^ o) << 2, __builtin_bit_cast(int, v))); }
__device__ __forceinline__ unsigned shxu(unsigned v, int o, int lane) { return (unsigned)__builtin_amdgcn_ds_bpermute((lane ^ o) << 2, (int)v); }
__device__ __forceinline__ float dpp_f(float v, const int ctrl) { return v; }
#define DPPADD(v, ctrl) ((v) + __builtin_bit_cast(float, __builtin_amdgcn_update_dpp(0, __builtin_bit_cast(int, (v)), (ctrl), 0xf, 0xf, true)))
__device__ __forceinline__ float wave_sum(float v, int lane) {
    (void)lane;
    v = DPPADD(v, 0xB1); v = DPPADD(v, 0x4E); v = DPPADD(v, 0x141); v = DPPADD(v, 0x140);
    const int b = __builtin_bit_cast(int, v);
    const float s0 = __builtin_bit_cast(float, __builtin_amdgcn_readlane(b, 0)), s1 = __builtin_bit_cast(float, __builtin_amdgcn_readlane(b, 16));
    const float s2 = __builtin_bit_cast(float, __builtin_amdgcn_readlane(b, 32)), s3 = __builtin_bit_cast(float, __builtin_amdgcn_readlane(b, 48));
    return (s0 + s1) + (s2 + s3);
}
__device__ __forceinline__ float silu_f(float v) { return v / (1.f + __expf(-v)); }
__device__ __forceinline__ float gelu_tanh(float v) { const float u = 0.7978845608028654f * (v + 0.044715f * v * v * v); const float e = __expf(2.f * u); return v * (1.f - 1.f / (e + 1.f)); }
__device__ __forceinline__ int lane_id() { int l; asm volatile("v_mbcnt_lo_u32_b32 %0, -1, 0\n\tv_mbcnt_hi_u32_b32 %0, -1, %0" : "=v"(l)); return l; }
__device__ __forceinline__ int crow(int r, int hi) { return (r & 3) + 8 * (r >> 2) + 4 * hi; }
__device__ __forceinline__ int mod_idx(int r) { return r < NLAT ? (r >> 13) : 4; }
__device__ __forceinline__ void tok_tile(int r, int& b, int& t, int& kk) {
    if (r < NLAT) { b = r >> 13; const int pos = r & 8191; t = pos >> 6; kk = pos & 63; }
    else { const int q = r - NLAT; b = q >> 8; const int pos = q & 255; t = 128 + (pos >> 6); kk = pos & 63; }
}
__device__ __forceinline__ int vtile_off(int kk, int d8) { return (d8 >> 2) * 4096 + (kk >> 4) * 1024 + (kk & 15) * 64 + (d8 & 3) * 16; }
__device__ __forceinline__ int ktile_off(int kk, int dc) { return dc * 1024 + kk * 16; }

namespace pg8 {
constexpr int BM = 256, BK = 64, HALF = 128, HTB = HALF * BK * 2, STAGE_BYTES = 8 * HTB, NXCD = 8, WGM = 8;
__host__ __device__ __forceinline__ int lds_byte(int r, int c) { const int st = (r >> 4) * 2 + (c >> 5), rr = r & 15, cc = c & 31, ob = rr * 64 + cc * 2; return st * 1024 + (ob ^ (((ob >> 9) & 1) << 5)); }
__host__ __device__ __forceinline__ void stage_rc(int b, int& R, int& C) { const int st = b / 1024, sb = b % 1024, swz = sb ^ (((sb >> 9) & 1) << 5); R = (st >> 1) * 16 + swz / 64; C = (st & 1) * 32 + (swz % 64) / 2; }
__host__ __device__ __forceinline__ int perm32(int rho) { const int n = rho >> 4, i = rho & 15; return 8 * (i >> 2) + 4 * n + (i & 3); }
struct Unit { int pm, pn, aux; };
struct Gemm { const bf16_t* A; const bf16_t* Bt; int lda; int K; };

struct StaticOrder {
    int nM, nN, nwg, G, c;
    __device__ void init(int M, int N, int G_, int c_) { nM = M / BM; nN = N / BM; nwg = nM * nN; G = G_; c = c_; }
    __device__ bool next(int i, Unit& u) const {
        const long L = (long)i * G + c; if (L >= nwg) return false;
        int wgid = (int)L; { const int q = nwg / NXCD, r = nwg % NXCD, xcd = wgid % NXCD, off = wgid / NXCD; wgid = (xcd < r ? xcd * (q + 1) : r * (q + 1) + (xcd - r) * q) + off; }
        const int nig = WGM * nN, gid = wgid / nig, fm = gid * WGM, gsz = (nM - fm) < WGM ? (nM - fm) : WGM;
        u.pm = fm + ((wgid % nig) % gsz); u.pn = (wgid % nig) / gsz; u.aux = 0; return true;
    }
};
struct PlainRows { static constexpr bool GATHER = false; int lda2; __device__ __forceinline__ unsigned tok(const Unit&, int) const { return 0u; } };

template <class Epi, class Sched, class ARows, bool ALIGN_EPI, bool SP2>
__device__ __forceinline__ void gemm_phase(LAS unsigned char* lds, const int tid, const Gemm g, const Sched& S, const ARows& AR, const Epi& E) {
    const int wid = __builtin_amdgcn_readfirstlane(tid >> 6), lane = tid & 63, wr = wid >> 2, wc = wid & 3, fr = lane & 15, fq = lane >> 4;
    int K = g.K; asm volatile("" : "+s"(K));
    const int nt = K / BK;
    int R0, C0; stage_rc(tid * 16, R0, C0);
    const unsigned lda2 = (unsigned)AR.lda2;
    const unsigned aLane = ARows::GATHER ? (unsigned)(C0 * 2) : (unsigned)R0 * lda2 + (unsigned)(C0 * 2);
    const unsigned voffB0 = (unsigned)(((R0 & ~31) + Epi::perm(R0 & 31)) * K + C0) * 2u;
    const size_t kstep = (size_t)(BK * 2);
    const size_t hstepB = (size_t)HALF * K * 2;
    const size_t tstepB = 2 * hstepB;
    const size_t qstepB = (size_t)64 * K * 2;
    const unsigned ldsw = (unsigned)wid * 1024u;
    const int aoff = lds_byte(wr * 64 + fr, fq * 8), boff = lds_byte(wc * 32 + fr, fq * 8);
#define PG8_SA(b, h) (((b) * 2 + (h)) * HTB)
#define PG8_SB(b, h) ((4 + (b) * 2 + (h)) * HTB)
#define PG8_STAGEB(bufoff, gbase) do { _Pragma("unroll") for (int _i = 0; _i < 2; ++_i) { \
        const char* _ub = (const char*)(gbase) + _i * qstepB; asm volatile("" : "+s"(_ub));     \
        __builtin_amdgcn_global_load_lds((const unsigned*)(_ub + voffB0), (LAS unsigned*)(lds + (bufoff) + ldsw + _i * 8192), 16, 0, 0); } } while (0)
#define PG8_STAGEA(bufoff, pm_, tk_, h, kb) do { _Pragma("unroll") for (int _i = 0; _i < 2; ++_i) { \
        const char* _ub; unsigned _vo; \
        if constexpr (ARows::GATHER) { _ub = (const char*)g.A + (kb); _vo = (((tk_)[h] >> (16 * _i)) & 0xffffu) * lda2 + aLane; } \
        else { _ub = (const char*)g.A + ((size_t)((pm_) * BM + (h) * HALF + _i * 64) * lda2 + (kb)); _vo = aLane; } \
        asm volatile("" : "+s"(_ub)); \
        __builtin_amdgcn_global_load_lds((const unsigned*)(_ub + _vo), (LAS unsigned*)(lds + (bufoff) + ldsw + _i * 8192), 16, 0, 0); } } while (0)
#define PG8_LDA(dst, b, h) do { _Pragma("unroll") for (int m = 0; m < 4; ++m) _Pragma("unroll") for (int k = 0; k < 2; ++k) dst[m][k] = *(const LAS bf16x8*)(lds + PG8_SA(b, h) + aoff + m * 2048 + k * 1024); } while (0)
#define PG8_LDB(dst, b, h) do { _Pragma("unroll") for (int n = 0; n < 2; ++n) _Pragma("unroll") for (int k = 0; k < 2; ++k) dst[n][k] = *(const LAS bf16x8*)(lds + PG8_SB(b, h) + boff + n * 2048 + k * 1024); } while (0)
#define PG8_MMA(ai, bj, At, Bt) do { __builtin_amdgcn_s_setprio(1); _Pragma("unroll") for (int m = 0; m < 4; ++m) _Pragma("unroll") for (int n = 0; n < 2; ++n) _Pragma("unroll") for (int k = 0; k < 2; ++k) \
        acc[ai][bj][m][n] = __builtin_amdgcn_mfma_f32_16x16x32_bf16(Bt[n][k], At[m][k], acc[ai][bj][m][n], 0, 0, 0); __builtin_amdgcn_s_setprio(0); } while (0)
#define PG8_WAIT_V(n) asm volatile("s_waitcnt vmcnt(" #n ")" ::: "memory")
#define PG8_WAIT_L(n) asm volatile("s_waitcnt lgkmcnt(" #n ")" ::: "memory")
#define PG8_BAR __builtin_amdgcn_s_barrier()
#define PG8_SCHED __builtin_amdgcn_sched_barrier(0)
#define PG8_TOKS(tk_, u) do { if constexpr (ARows::GATHER) { _Pragma("unroll") for (int _h = 0; _h < 2; ++_h) (tk_)[_h] = AR.tok((u), _h * HALF + R0) | (AR.tok((u), _h * HALF + 64 + R0) << 16); } } while (0)
    Unit cur, nxt; int ui = 0;
    if (!S.next(0, cur)) return;
    cur.pm = __builtin_amdgcn_readfirstlane(cur.pm); cur.pn = __builtin_amdgcn_readfirstlane(cur.pn); cur.aux = __builtin_amdgcn_readfirstlane(cur.aux);
    f32x4 acc[2][2][4][2];
#pragma unroll
    for (int a = 0; a < 2; ++a)
#pragma unroll
        for (int b = 0; b < 2; ++b)
#pragma unroll
            for (int m = 0; m < 4; ++m)
#pragma unroll
                for (int n = 0; n < 2; ++n) acc[a][b][m][n] = (f32x4){0.f, 0.f, 0.f, 0.f};
    bf16x8 At[4][2], B0[2][2], B1[2][2];
    unsigned tkC[2] = {0u, 0u}, tkN[2] = {0u, 0u};
    PG8_TOKS(tkC, cur);
    const char* cB = (const char*)g.Bt + (size_t)cur.pn * tstepB;
    static_assert(SP2, "only the SP2 loop is kept");
    PG8_STAGEB(PG8_SB(0, 0), cB); PG8_STAGEB(PG8_SB(0, 1), cB + hstepB); PG8_STAGEA(PG8_SA(0, 0), cur.pm, tkC, 0, 0); PG8_STAGEA(PG8_SA(0, 1), cur.pm, tkC, 1, 0);
    if (wr == 1) PG8_BAR;
    PG8_WAIT_V(2); PG8_BAR;
    PG8_STAGEB(PG8_SB(1, 0), cB + kstep); PG8_STAGEA(PG8_SA(1, 0), cur.pm, tkC, 0, kstep); PG8_STAGEB(PG8_SB(1, 1), cB + hstepB + kstep);
    PG8_WAIT_V(6); PG8_BAR;
    for (;;) {
        const bool has_next = S.next(ui + 1, nxt);
        if (!has_next) nxt = cur;
        nxt.pm = __builtin_amdgcn_readfirstlane(nxt.pm); nxt.pn = __builtin_amdgcn_readfirstlane(nxt.pn); nxt.aux = __builtin_amdgcn_readfirstlane(nxt.aux);
        PG8_TOKS(tkN, nxt);
        const char* nB = (const char*)g.Bt + (size_t)nxt.pn * tstepB;
        for (int t = 0; t < nt; t += 2) {
            const bool last = (t == nt - 2);
            const size_t k1 = (size_t)(t + 1) * kstep;
            const size_t k2 = last ? 0 : (size_t)(t + 2) * kstep, k3 = k2 + kstep;
            const int pm2 = last ? nxt.pm : cur.pm;
            const char* b2 = last ? nB : cB + (size_t)(t + 2) * kstep; const char* b3 = b2 + kstep;
            PG8_LDB(B0, 0, 0); PG8_LDB(B1, 0, 1); PG8_SCHED; PG8_LDA(At, 0, 0); PG8_STAGEA(PG8_SA(1, 1), cur.pm, tkC, 1, k1);
            PG8_WAIT_V(8); PG8_WAIT_L(0); PG8_BAR; PG8_MMA(0, 0, At, B0); PG8_MMA(0, 1, At, B1); PG8_BAR; PG8_SCHED;
            PG8_LDA(At, 0, 1); PG8_STAGEB(PG8_SB(0, 0), b2); PG8_STAGEB(PG8_SB(0, 1), b2 + hstepB); if (last) PG8_STAGEA(PG8_SA(0, 0), pm2, tkN, 0, k2); else PG8_STAGEA(PG8_SA(0, 0), pm2, tkC, 0, k2);
            PG8_WAIT_V(8); PG8_WAIT_L(0); PG8_BAR; PG8_MMA(1, 0, At, B0); PG8_MMA(1, 1, At, B1); PG8_BAR; PG8_SCHED;
            PG8_LDB(B0, 1, 0); PG8_LDB(B1, 1, 1); PG8_SCHED; PG8_LDA(At, 1, 0); if (last) PG8_STAGEA(PG8_SA(0, 1), pm2, tkN, 1, k2); else PG8_STAGEA(PG8_SA(0, 1), pm2, tkC, 1, k2);
            PG8_WAIT_V(8); PG8_WAIT_L(0); PG8_BAR; PG8_MMA(0, 0, At, B0); PG8_MMA(0, 1, At, B1); PG8_BAR; PG8_SCHED;
            PG8_LDA(At, 1, 1); PG8_STAGEB(PG8_SB(1, 0), b3); PG8_STAGEB(PG8_SB(1, 1), b3 + hstepB); if (last) PG8_STAGEA(PG8_SA(1, 0), pm2, tkN, 0, k3); else PG8_STAGEA(PG8_SA(1, 0), pm2, tkC, 0, k3);
            PG8_WAIT_V(8); PG8_WAIT_L(0); PG8_BAR; PG8_MMA(1, 0, At, B0); PG8_MMA(1, 1, At, B1); PG8_BAR; PG8_SCHED;
        }
        if constexpr (ALIGN_EPI) { if (wr == 0) PG8_BAR; }
        E(acc, cur, wr, wc, fr, fq);
        if (!has_next) break;
#pragma unroll
        for (int a = 0; a < 2; ++a)
#pragma unroll
            for (int b = 0; b < 2; ++b)
#pragma unroll
                for (int m = 0; m < 4; ++m)
#pragma unroll
                    for (int n = 0; n < 2; ++n) acc[a][b][m][n] = (f32x4){0.f, 0.f, 0.f, 0.f};
        cur = nxt; cB = nB; ++ui;
#pragma unroll
        for (int _h = 0; _h < 2; ++_h) tkC[_h] = tkN[_h];
        if constexpr (ALIGN_EPI) { if (wr == 1) PG8_BAR; }
    }
    PG8_WAIT_V(0);
    if constexpr (!ALIGN_EPI) { if (wr == 0) PG8_BAR; }
    PG8_BAR;
#undef PG8_SA
#undef PG8_SB
#undef PG8_STAGEA
#undef PG8_STAGEB
#undef PG8_LDA
#undef PG8_LDB
#undef PG8_MMA
#undef PG8_WAIT_V
#undef PG8_WAIT_L
#undef PG8_BAR
#undef PG8_SCHED
#undef PG8_TOKS
}
}
__device__ __forceinline__ u32x4 pack8(const f32x4 a, const f32x4 b, float s) { u32x4 w; w.x = pk2(a[0] * s, a[1] * s); w.y = pk2(a[2] * s, a[3] * s); w.z = pk2(b[0] * s, b[1] * s); w.w = pk2(b[2] * s, b[3] * s); return w; }

struct EpiZ {
    static __host__ __device__ __forceinline__ int perm(int r) { return pg8::perm32(r); }
    bf16_t* Z; unsigned char* NK; unsigned char* NV;
    __device__ __forceinline__ void operator()(const f32x4 (&acc)[2][2][4][2], const pg8::Unit& u, int wr, int wc, int fr, int fq) const {
        const int pn = u.pn;
        if (pn == 6 || pn == 7) {
            const int b = u.pm < 128 ? (u.pm >> 5) : (u.pm - 128), t0 = u.pm < 128 ? (u.pm & 31) * 4 : 128;
#pragma unroll
            for (int bj = 0; bj < 2; ++bj) { const int col = bj * 128 + wc * 32 + 8 * fq; const int h = col >> 6, d8 = (col & 63) >> 3;
                unsigned char* tb = (pn == 6 ? NK : NV) + (size_t)((b * 4 + h) * NTILE + t0 + wr) * 8192;
                const int lo = pn == 6 ? (d8 * 1024 + fr * 16) : ((d8 >> 2) * 4096 + fr * 64 + (d8 & 3) * 16);
#pragma unroll
                for (int ai = 0; ai < 2; ++ai)
#pragma unroll
                    for (int m = 0; m < 4; ++m) *(u32x4*)(tb + ai * 2 * 8192 + (pn == 6 ? m * 256 : m * 1024) + lo) = pack8(acc[ai][bj][m][0], acc[ai][bj][m][1], 1.f); }
        } else {
            const float s = pn == 5 ? NA_QSCALE : 1.f;
            #pragma unroll
            for (int ai = 0; ai < 2; ++ai)
            #pragma unroll
            for (int m = 0; m < 4; ++m) { const int rl = ai * 128 + wr * 64 + m * 16 + fr; const int row = u.pm * 256 + rl; (void)rl; (void)row;
                bf16_t* rowp = Z + (size_t)row * ZP + pn * 256 + wc * 32 + 8 * fq;
#pragma unroll
                for (int bj = 0; bj < 2; ++bj) *(u32x4*)(rowp + bj * 128) = pack8(acc[ai][bj][m][0], acc[ai][bj][m][1], s);
            }
        }
    }
};

struct EpiQ {
    static __host__ __device__ __forceinline__ int perm(int r) { return pg8::perm32(r); }
    bf16_t* QM;
    __device__ __forceinline__ void operator()(const f32x4 (&acc)[2][2][4][2], const pg8::Unit& u, int wr, int wc, int fr, int fq) const {
#pragma unroll
        for (int ai = 0; ai < 2; ++ai)
#pragma unroll
            for (int m = 0; m < 4; ++m) { const int row = u.pm * 256 + ai * 128 + wr * 64 + m * 16 + fr;
#pragma unroll
                for (int bj = 0; bj < 2; ++bj) { const int cb = u.pn * 256 + bj * 128 + wc * 32;
                    if (cb < 384) *(u32x4*)(QM + (size_t)row * 384 + cb + 8 * fq) = pack8(acc[ai][bj][m][0], acc[ai][bj][m][1], MLA_QSCALE); } }
    }
};

struct EpiKV {
    static __host__ __device__ __forceinline__ int perm(int r) { return pg8::perm32(r); }
    unsigned char* MK; unsigned char* MV;
    __device__ __forceinline__ void operator()(const f32x4 (&acc)[2][2][4][2], const pg8::Unit& u, int wr, int wc, int fr, int fq) const {
        const int b = u.pm < 128 ? (u.pm >> 5) : (u.pm - 128), t0 = u.pm < 128 ? (u.pm & 31) * 4 : 128;
#pragma unroll
        for (int bj = 0; bj < 2; ++bj) { const int col = u.pn * 256 + bj * 128 + wc * 32 + 8 * fq; const int h = col >> 7, isv = (col >> 6) & 1, d8 = (col & 63) >> 3;
            const size_t tile = (size_t)((b * 4 + h) * NTILE + t0 + wr);
            if (isv) { unsigned char* tb = MV + tile * VB + (d8 >> 2) * 4096 + fr * 64 + (d8 & 3) * 16;
#pragma unroll
                for (int ai = 0; ai < 2; ++ai)
#pragma unroll
                    for (int m = 0; m < 4; ++m) *(u32x4*)(tb + ai * 2 * VB + m * 1024) = pack8(acc[ai][bj][m][0], acc[ai][bj][m][1], 1.f);
            } else { unsigned char* tb = MK + tile * MKB + d8 * 1024 + fr * 16;
#pragma unroll
                for (int ai = 0; ai < 2; ++ai)
#pragma unroll
                    for (int m = 0; m < 4; ++m) *(u32x4*)(tb + ai * 2 * MKB + m * 256) = pack8(acc[ai][bj][m][0], acc[ai][bj][m][1], 1.f); } }
    }
};

struct EpiOut {
    static __host__ __device__ __forceinline__ int perm(int r) { return pg8::perm32(r); }
    const float* res_lat; const float* res_ctx; float* x_lat; float* x_ctx; const float* g1;
    __device__ __forceinline__ void operator()(const f32x4 (&acc)[2][2][4][2], const pg8::Unit& u, int wr, int wc, int fr, int fq) const {
        const bool latent = u.pm < 128;
        const int bb = latent ? (u.pm >> 5) : 4;
        const float* rbase = latent ? res_lat : res_ctx - (size_t)NLAT * D;
        float* xbase = latent ? x_lat : x_ctx - (size_t)NLAT * D;
        const int c0 = u.pn * 256 + wc * 32 + 8 * fq;
        f32x4 gv[2][2];
#pragma unroll
        for (int bj = 0; bj < 2; ++bj)
#pragma unroll
            for (int n = 0; n < 2; ++n) gv[bj][n] = *(const f32x4*)(g1 + bb * 6144 + c0 + bj * 128 + 4 * n);
        #pragma unroll
        for (int ai = 0; ai < 2; ++ai)
        #pragma unroll
        for (int m = 0; m < 4; ++m) { const int rl = ai * 128 + wr * 64 + m * 16 + fr; const int row = u.pm * 256 + rl; (void)rl; (void)row;
#pragma unroll
            for (int bj = 0; bj < 2; ++bj)
#pragma unroll
                for (int n = 0; n < 2; ++n) { const size_t off = (size_t)row * D + c0 + bj * 128 + 4 * n;
                    const f32x4 r = *(const f32x4*)(rbase + off); *(f32x4*)(xbase + off) = r + gv[bj][n] * acc[ai][bj][m][n]; }
        }
    }
};

struct EpiMoe1 {
    static __host__ __device__ __forceinline__ int perm(int r) { return pg8::perm32(r); }
    bf16_t* H1;
    __device__ __forceinline__ void operator()(const f32x4 (&acc)[2][2][4][2], const pg8::Unit& u, int wr, int wc, int fr, int fq) const {
        #pragma unroll
        for (int ai = 0; ai < 2; ++ai)
        #pragma unroll
        for (int m = 0; m < 4; ++m) { const int rl = ai * 128 + wr * 64 + m * 16 + fr; const int row = u.pm * 256 + rl; (void)rl; (void)row;
            f32x4 h0; f32x4 h1;
#pragma unroll
            for (int e = 0; e < 4; ++e) { h0[e] = silu_f(acc[ai][0][m][0][e]) * acc[ai][1][m][0][e]; h1[e] = silu_f(acc[ai][0][m][1][e]) * acc[ai][1][m][1][e]; }
            *(u32x4*)(H1 + (size_t)row * DE + (u.pn & 3) * 128 + wc * 32 + 8 * fq) = pack8(h0, h1, 1.f);
        }
    }
};
struct EpiMoe2 {
    static __host__ __device__ __forceinline__ int perm(int r) { return pg8::perm32(r); }
    bf16_t* Y;
    __device__ __forceinline__ void operator()(const f32x4 (&acc)[2][2][4][2], const pg8::Unit& u, int wr, int wc, int fr, int fq) const {
        #pragma unroll
        for (int ai = 0; ai < 2; ++ai)
        #pragma unroll
        for (int m = 0; m < 4; ++m) { const int rl = ai * 128 + wr * 64 + m * 16 + fr; const int row = u.pm * 256 + rl; (void)rl; (void)row;
            bf16_t* rowp = Y + (size_t)row * D + (u.pn & 3) * 256 + wc * 32 + 8 * fq;
#pragma unroll
            for (int bj = 0; bj < 2; ++bj) *(u32x4*)(rowp + bj * 128) = pack8(acc[ai][bj][m][0], acc[ai][bj][m][1], 1.f);
        }
    }
};

struct MoeOrder {
    const LAS int* tb; int G, c;
    __device__ __forceinline__ bool next(int i, pg8::Unit& u) const {
        const int L = i * G + c; const int ntl = tb[32];
        if (L >= ntl * 4) return false;
        const int rt = L >> 2; int e = 0;
        for (int j = 1; j < 32; ++j) e += (tb[j] <= rt) ? 1 : 0;
        u.pm = rt; u.pn = e * 4 + (L & 3); u.aux = e; return true;
    }
};
struct MoeRows1 {
    static constexpr bool GATHER = true;
    int lda2; const LAS int* tb; const LAS int* cn; const int* list;
    __device__ __forceinline__ unsigned tok(const pg8::Unit& u, int lr) const {
        const int e = u.aux; int j = (u.pm - tb[e]) * 256 + lr; const int c = cn[e]; j = j < c ? j : c - 1;
        return (unsigned)(*(const int*)((const char*)list + (size_t)e * MT * 4 + (size_t)(unsigned)(j * 4)) >> 1);
    }
};
__device__ __forceinline__ s16x4 vtr(const LAS unsigned char* p) { typedef short v4i16_t __attribute__((ext_vector_type(4))); return __builtin_bit_cast(s16x4, __builtin_amdgcn_ds_read_tr16_b64_v4i16((LAS v4i16_t*)p)); }

__device__ __forceinline__ void glds16(const void* gsrc, unsigned lds_dst) { unsigned keep;
    asm volatile("s_mov_b32 %0, m0\n\ts_mov_b32 m0, %2\n\ts_nop 0\n\tglobal_load_lds_dwordx4 %1, off\n\ts_mov_b32 m0, %0" : "=&s"(keep) : "v"(gsrc), "s"(lds_dst) : "memory"); }

__device__ __forceinline__ float max3f(float a, float b, float c) { float r; asm("v_max3_f32 %0, %1, %2, %3" : "=v"(r) : "v"(a), "v"(b), "v"(c)); return r; }
__device__ __forceinline__ float max2f(float a, float b) { float r; asm("v_max_f32_e32 %0, %1, %2" : "=v"(r) : "v"(a), "v"(b)); return r; }
__device__ __forceinline__ float fadd_s(float a, float b) { float r; asm("v_add_f32_e32 %0, %1, %2" : "=v"(r) : "v"(a), "v"(b)); return r; }

struct NaInfo { int active_lo, active_hi;
                int qrow, qcol, c0; const LAS float* tab; };

template <int KS, bool ISNA, bool ROPEQ>
__device__ __forceinline__ void attn_unit(LAS unsigned char* lds, const int tid, const bf16_t* Qw  , int qpitch,
                                          const unsigned char* Kt, const unsigned char* Vt, int a0, int na, int nb, bf16_t* Ow, const NaInfo& ni, const float* rope_row  ) {
    constexpr int KB = KS * 2048, TB = KB + 8192, NPK = KB / 1024, NP = NPK + 8;
    const int lane = tid & 63, r32 = lane & 31, hi = lane >> 5; const int wid = __builtin_amdgcn_readfirstlane(tid >> 6);
    const int NT = na + nb;
#define TIX(i) ((i) < na ? a0 + (i) : 128 + (i) - na)
    const unsigned lds0 = (unsigned)(__UINTPTR_TYPE__)lds;
#define ISSUE(i, slot) do { const int tx_ = TIX(i); _Pragma("unroll") for (int pp = 0; pp < 3; ++pp) { const int p_ = wid + 8 * pp; if (p_ < NP) { \
        const unsigned char* src_ = (p_ < NPK) ? (Kt + (size_t)tx_ * KB + p_ * 1024) : (Vt + (size_t)tx_ * VB + (p_ - NPK) * 1024); \
        glds16(src_ + lane * 16, (unsigned)__builtin_amdgcn_readfirstlane(lds0 + (slot) * TB + p_ * 1024)); } } } while (0)
#define WAITBAR(N) asm volatile("s_waitcnt vmcnt(" #N ") lgkmcnt(0)\n\ts_barrier" ::: "memory")
    const bool w3 = (NP > 16) && (wid < NP - 16);
    ISSUE(0, 0);
    if (NT > 1) ISSUE(1, 1);
    bf16x8 qf[KS];
#pragma unroll
    for (int s = 0; s < KS; ++s) qf[s] = *(const bf16x8*)(Qw + (size_t)r32 * qpitch + s * 16 + hi * 8);
    if constexpr (ROPEQ) {
        static_assert(KS == 6, "rope only on the MLA query");
        const float* rt = rope_row + (size_t)r32 * 32;
        const float sg = hi ? 1.f : -1.f;
#pragma unroll
        for (int s = 4; s < 6; ++s) {
            u32x4 w = __builtin_bit_cast(u32x4, qf[s]); u32x4 pw; u32x4 ow;
#pragma unroll
            for (int e = 0; e < 4; ++e) pw[e] = shxu(w[e], 32, lane);
#pragma unroll
            for (int e = 0; e < 4; ++e) { const f32x4 cs = *(const f32x4*)(rt + (s - 4) * 16 + 4 * e);
                const float lo = bf_lo(w[e]) * cs[0] + sg * bf_lo(pw[e]) * cs[1], hh = bf_hi(w[e]) * cs[2] + sg * bf_hi(pw[e]) * cs[3];
                ow[e] = pk2(lo, hh); }
            qf[s] = __builtin_bit_cast(bf16x8, ow);
        }
    }
    f32x16 o0 = {}, o1 = {};
    f32x16 negm = {};
    f32x16 p0 = {}, p1 = {};
    float mrun = 0.f, lrun = 0.f;
    bool first = true;
#define STAGE_QK(i, b) do { \
        const LAS unsigned char* kb_ = lds + (b) * TB + hi * 1024 + r32 * 16; \
        bf16x8 kf_[2 * KS]; \
        _Pragma("unroll") for (int s = 0; s < KS; ++s) { kf_[2 * s] = *(const LAS bf16x8*)(kb_ + s * 2048); kf_[2 * s + 1] = *(const LAS bf16x8*)(kb_ + s * 2048 + 512); } \
        __builtin_amdgcn_sched_barrier(0); \
        __builtin_amdgcn_s_setprio(1); \
        _Pragma("unroll") for (int s = 0; s < KS; ++s) { \
            p0 = __builtin_amdgcn_mfma_f32_32x32x16_bf16(kf_[2 * s], qf[s], s == 0 ? negm : p0, 0, 0, 0); \
            p1 = __builtin_amdgcn_mfma_f32_32x32x16_bf16(kf_[2 * s + 1], qf[s], s == 0 ? negm : p1, 0, 0, 0); } \
        __builtin_amdgcn_s_setprio(0); \
        if (ISNA && (i) < na) { const int dr_ = a0 + (i) - ni.qrow + 7; \
            int ib_ = 4 * hi - ni.qcol + 63, wb_ = 4 * hi - ni.c0; asm volatile("" : "+v"(ib_), "+v"(wb_));     \
            const LAS float* trow = ni.tab + dr_ * 128 + ib_;        \
            _Pragma("unroll") for (int r = 0; r < 16; ++r) { \
                const int c_ = (r & 3) + 8 * (r >> 2); \
                const float b0 = trow[c_], b1 = trow[c_ + 32]; \
                p0[r] = ((unsigned)(wb_ + c_) < 16u) ? p0[r] + b0 : -1e30f; \
                p1[r] = ((unsigned)(wb_ + c_ + 32) < 16u) ? p1[r] + b1 : -1e30f; } } \
    } while (0)
#define STAGE_SMPV(b) do { \
        const LAS unsigned char* vb_ = lds + (b) * TB + KB + ((lane >> 4) & 1) * 32 + (lane & 3) * 8 + (4 * hi + ((lane & 15) >> 2)) * 64; \
        s16x4 vl0[4], vh0[4], vl1[4], vh1[4]; \
        _Pragma("unroll") for (int ks = 0; ks < 4; ++ks) { vl0[ks] = vtr(vb_ + ks * 1024); vh0[ks] = vtr(vb_ + ks * 1024 + 512); vl1[ks] = vtr(vb_ + 4096 + ks * 1024); vh1[ks] = vtr(vb_ + 4096 + ks * 1024 + 512); } \
        __builtin_amdgcn_sched_barrier(0); \
        asm volatile("s_nop 15\n\ts_nop 7" : "+v"(p0), "+v"(p1));     \
        float mxa = max3f(p0[0], p0[1], p1[0]), mxb = max3f(p0[2], p0[3], p1[1]); mxa = max3f(mxa, p1[2], p1[3]); \
        _Pragma("unroll") for (int r = 4; r < 16; r += 4) { mxa = max3f(mxa, p0[r], p0[r + 1]); mxb = max3f(mxb, p0[r + 2], p0[r + 3]); mxa = max3f(mxa, p1[r], p1[r + 1]); mxb = max3f(mxb, p1[r + 2], p1[r + 3]); } \
        float mx = max2f(mxa, mxb); \
        mx = max2f(mx, shx(mx, 32, lane)); \
          \
        if (first || __any(mx > 8.0f)) { \
            const float dl = first ? mx : fmaxf(mx, 0.f); \
            const float alpha = __builtin_amdgcn_exp2f(-dl);       \
            mrun += dl; lrun *= alpha; \
            _Pragma("unroll") for (int r = 0; r < 16; ++r) { p0[r] -= dl; p1[r] -= dl; o0[r] *= alpha; o1[r] *= alpha; negm[r] = -mrun; } \
            first = false; } \
        float psa = 0.f, psb = 0.f; \
        _Pragma("unroll") for (int r = 0; r < 16; ++r) { p0[r] = __builtin_amdgcn_exp2f(p0[r]); p1[r] = __builtin_amdgcn_exp2f(p1[r]); psa += p0[r]; psb += p1[r]; } \
        lrun += psa + psb; \
        bf16x8 pf[4]; \
        { u32x4 w; \
          w.x = pk2(p0[0], p0[1]); w.y = pk2(p0[2], p0[3]); w.z = pk2(p0[4], p0[5]); w.w = pk2(p0[6], p0[7]); pf[0] = __builtin_bit_cast(bf16x8, w); \
          w.x = pk2(p0[8], p0[9]); w.y = pk2(p0[10], p0[11]); w.z = pk2(p0[12], p0[13]); w.w = pk2(p0[14], p0[15]); pf[1] = __builtin_bit_cast(bf16x8, w); \
          w.x = pk2(p1[0], p1[1]); w.y = pk2(p1[2], p1[3]); w.z = pk2(p1[4], p1[5]); w.w = pk2(p1[6], p1[7]); pf[2] = __builtin_bit_cast(bf16x8, w); \
          w.x = pk2(p1[8], p1[9]); w.y = pk2(p1[10], p1[11]); w.z = pk2(p1[12], p1[13]); w.w = pk2(p1[14], p1[15]); pf[3] = __builtin_bit_cast(bf16x8, w); } \
        _Pragma("unroll") for (int ks = 0; ks < 4; ++ks) { \
            const bf16x8 va0 = {vl0[ks][0], vl0[ks][1], vl0[ks][2], vl0[ks][3], vh0[ks][0], vh0[ks][1], vh0[ks][2], vh0[ks][3]}; \
            const bf16x8 va1 = {vl1[ks][0], vl1[ks][1], vl1[ks][2], vl1[ks][3], vh1[ks][0], vh1[ks][1], vh1[ks][2], vh1[ks][3]}; \
            o0 = __builtin_amdgcn_mfma_f32_32x32x16_bf16(va0, pf[ks], o0, 0, 0, 0); \
            o1 = __builtin_amdgcn_mfma_f32_32x32x16_bf16(va1, pf[ks], o1, 0, 0, 0); } \
    } while (0)
    for (int i = 0; i < NT; ++i) {
        if (i + 1 < NT) { if (w3) WAITBAR(3); else WAITBAR(2); } else WAITBAR(0);
        if (i + 2 < NT) ISSUE(i + 2, (i + 2) & 3);
        bool active = true;
        if (ISNA && i < na) { const int krow = a0 + i; active = (krow >= ni.active_lo) && (krow <= ni.active_hi); }
        if (active) { STAGE_QK(i, (i & 3)); STAGE_SMPV((i & 3)); }
    }
    asm volatile("s_waitcnt lgkmcnt(0)\n\ts_barrier" ::: "memory");
    const float ltot = lrun + shx(lrun, 32, lane);
    const float inv = 1.0f / ltot;
    bf16_t* orow = Ow + (size_t)r32 * D;
#pragma unroll
    for (int g = 0; g < 4; ++g) {
        u32x2 w0, w1;
        w0.x = pk2(o0[4 * g] * inv, o0[4 * g + 1] * inv); w0.y = pk2(o0[4 * g + 2] * inv, o0[4 * g + 3] * inv);
        w1.x = pk2(o1[4 * g] * inv, o1[4 * g + 1] * inv); w1.y = pk2(o1[4 * g + 2] * inv, o1[4 * g + 3] * inv);
        *(u32x2*)(orow + 8 * g + 4 * hi) = w0;
        *(u32x2*)(orow + 32 + 8 * g + 4 * hi) = w1;
    }
#undef TIX
#undef ISSUE
#undef WAITBAR
#undef STAGE_QK
#undef STAGE_SMPV
}
#define XB_TMO      128
#define XB_XCNT(j)  (256  + 64 * (j))
#define XB_XSUB(j)  (1280 + 64 * (j))
#define XB_XGEN(j)  (2304 + 64 * (j))
#define XB_TOP      3328
#define XB_TOPGEN   3392
#define XCD_BAR_WORDS 3456
#define XB_SPIN_CAP (1u << 18)
__device__ __forceinline__ unsigned xb_ld(unsigned* p)              { return __hip_atomic_load(p, __ATOMIC_RELAXED, __HIP_MEMORY_SCOPE_AGENT); }
__device__ __forceinline__ unsigned xb_add(unsigned* p, unsigned v) { return __hip_atomic_fetch_add(p, v, __ATOMIC_RELAXED, __HIP_MEMORY_SCOPE_AGENT); }
__device__ __forceinline__ unsigned xb_xcc_id() { return (unsigned)__builtin_amdgcn_s_getreg((3 << 11) | 20) & 0xFu; }
#define XB_SPIN(cond, bar) do { unsigned _sp = 0; while (cond) { __builtin_amdgcn_s_sleep(1); \
    if ((++_sp & 255u) == 0u) { if (xb_ld(&(bar)[XB_TMO])) break; if (_sp > XB_SPIN_CAP) { atomicAdd(&(bar)[XB_TMO], 1u); break; } } } } while (0)
struct XcdBarrier { unsigned* bar; unsigned x; volatile LAS unsigned* st; };
__device__ __forceinline__ XcdBarrier xcd_barrier_post(unsigned* bar, volatile LAS unsigned* st, int tid) {
    XcdBarrier b; b.bar = bar; b.x = xb_xcc_id(); b.st = st;
    if (tid == 0) (void)xb_add(&bar[XB_XCNT(b.x)], 1u);
    return b;
}
__device__ __forceinline__ void xcd_barrier_complete(unsigned* bar, unsigned x, unsigned& nloc, unsigned& nx) {
    const unsigned G = gridDim.x * gridDim.y * gridDim.z;
    unsigned sum, cnt, mine, sp = 0u;
    for (;;) {
        sum = 0u; cnt = 0u; mine = 0u;
#pragma unroll
        for (unsigned j = 0; j < 16; ++j) { const unsigned c = xb_ld(&bar[XB_XCNT(j)]); sum += c; cnt += (c > 0u) ? 1u : 0u; mine = (j == x) ? c : mine; }
        if (sum == G) break;
        __builtin_amdgcn_s_sleep(1);
        if ((++sp & 255u) == 0u) { if (xb_ld(&bar[XB_TMO])) break; if (sp > XB_SPIN_CAP) { atomicAdd(&bar[XB_TMO], 1u); break; } }
    }
    nloc = mine > 0u ? mine : 1u; nx = cnt > 0u ? cnt : 1u;
}
__device__ __forceinline__ void xcd_barrier(const XcdBarrier& b, int tid) {
    asm volatile("s_waitcnt vmcnt(0)" ::: "memory");
    __syncthreads();
    if (tid == 0) {
        unsigned* bar = b.bar;
        __builtin_amdgcn_s_waitcnt(0);
        unsigned nloc = b.st[0], nx = b.st[1];
        if (nloc == 0u) { xcd_barrier_complete(bar, b.x, nloc, nx); b.st[0] = nloc; b.st[1] = nx; }
        const unsigned old = xb_add(&bar[XB_XSUB(b.x)], 1u);
        const unsigned gen = old / nloc;
        if (old + 1u == (gen + 1u) * nloc) {
            __builtin_amdgcn_fence(__ATOMIC_RELEASE, "agent");
            asm volatile("s_waitcnt vmcnt(0)" ::: "memory");
            const unsigned og = xb_add(&bar[XB_TOP], 1u);
            const unsigned tg = og / nx;
            if (og + 1u == (tg + 1u) * nx) xb_add(&bar[XB_TOPGEN], 1u);
            else XB_SPIN(xb_ld(&bar[XB_TOPGEN]) == tg, bar);
            __builtin_amdgcn_fence(__ATOMIC_ACQUIRE, "agent");
            xb_add(&bar[XB_XGEN(b.x)], 1u);
            asm volatile("s_waitcnt vmcnt(0)" ::: "memory");
        } else {
            XB_SPIN(xb_ld(&bar[XB_XGEN(b.x)]) == gen, bar);
            __builtin_amdgcn_fence(__ATOMIC_ACQUIRE, "agent");
            asm volatile("s_waitcnt vmcnt(0)" ::: "memory");
        }
    }
    __syncthreads();
}

struct Args { const float* in[27]; float* out; unsigned char* ws; int l_lo, l_hi, ph_lo, ph_hi, flags, pad; };
enum { I_X = 0, I_C, I_CTX, I_CCTX, I_WADA, I_BADA, I_N1G, I_N2G, I_WIN, I_CONVW, I_SGW, I_SGB, I_RPB, I_QNG, I_WUQ, I_KVNG, I_WUKV, I_ONG, I_WOUT, I_WGRP, I_BGRP, I_WEXP, I_BEXP, I_WGATE, I_WUP, I_WDOWN, I_FNG };

struct Frame {
    LAS unsigned char* lds; unsigned char* ws; float* out;
    int tid, lane, wave, G, vcu, gw, NGW, bx, wave0;
};

__device__ __forceinline__ void transpose_item(const float* W, int ldw, int K, bf16_t* WT, int k0, int n0, int drow, LAS float* scr, int lane) {
#pragma unroll 8
    for (int i = 0; i < 32; ++i) { const int kk = 2 * i + (lane >> 5); scr[kk * 33 + (lane & 31)] = W[(size_t)(k0 + kk) * ldw + n0 + (lane & 31)]; }
    asm volatile("s_waitcnt lgkmcnt(0)" ::: "memory");
    const int c = lane & 7;
#pragma unroll
    for (int j = 0; j < 4; ++j) { const int n = (lane >> 3) + 8 * j; const LAS float* s = scr + (8 * c) * 33 + n;
        u32x4 o; o.x = pk2(s[0 * 33], s[1 * 33]); o.y = pk2(s[2 * 33], s[3 * 33]); o.z = pk2(s[4 * 33], s[5 * 33]); o.w = pk2(s[6 * 33], s[7 * 33]);
        *(u32x4*)(WT + (size_t)(drow + n) * K + k0 + 8 * c) = o; }
    asm volatile("s_waitcnt lgkmcnt(0)" ::: "memory");
}

__device__ __forceinline__ void phase_prologue(Frame& F, const Args& A) {
    LAS float* scr = (LAS float*)(F.lds + F.wave * 8448);
    unsigned char* ws = F.ws;
    constexpr int IT_IN = 16 * 77, IT_OUT = 16 * 32, IT_UQ = 4 * 12, IT_UKV = 2 * 16, IT_G = 16 * 16, IT_D = 8 * 32;
    constexpr int IT_LAYER = IT_IN + IT_OUT + IT_UQ + IT_UKV + NE * (2 * IT_G + IT_D);
    for (int it = F.gw; it < NL * IT_LAYER; it += F.NGW) {
        const int l = it / IT_LAYER; int r = it % IT_LAYER;
        if (r < IT_IN) { const int kb = r / 77, nb = r % 77; transpose_item(A.in[I_WIN] + (size_t)l * D * ZC, ZC, D, (bf16_t*)(ws + WS_WIN) + (size_t)l * ZP * D, 64 * kb, 32 * nb, 32 * nb, scr, F.lane); continue; } r -= IT_IN;
        if (r < IT_OUT) { const int kb = r / 32, nb = r % 32; transpose_item(A.in[I_WOUT] + (size_t)l * D * D, D, D, (bf16_t*)(ws + WS_WOUT) + (size_t)l * D * D, 64 * kb, 32 * nb, 32 * nb, scr, F.lane); continue; } r -= IT_OUT;
        if (r < IT_UQ) { const int kb = r / 12, nb = r % 12; transpose_item(A.in[I_WUQ] + (size_t)l * 256 * 384, 384, 256, (bf16_t*)(ws + WS_WUQ) + (size_t)l * 512 * 256, 64 * kb, 32 * nb, 32 * nb, scr, F.lane); continue; } r -= IT_UQ;
        if (r < IT_UKV) { const int kb = r / 16, nb = r % 16; transpose_item(A.in[I_WUKV] + (size_t)l * 128 * 512, 512, 128, (bf16_t*)(ws + WS_WUKV) + (size_t)l * 512 * 128, 64 * kb, 32 * nb, 32 * nb, scr, F.lane); continue; } r -= IT_UKV;
        const int e = r / (2 * IT_G + IT_D); r %= (2 * IT_G + IT_D);
        const size_t le = (size_t)l * NE + e;
        if (r < 2 * IT_G) { const int up = r >= IT_G; if (up) r -= IT_G; const int kb = r / 16, nb = r % 16; const int n0 = 32 * nb;
            transpose_item(A.in[up ? I_WUP : I_WGATE] + le * D * DE, DE, D, (bf16_t*)(ws + WS_W1) + le * 1024 * 1024, 64 * kb, n0, (n0 >> 7) * 256 + (n0 & 127) + (up ? 128 : 0), scr, F.lane); continue; }
        r -= 2 * IT_G;
        { const int kb = r / 32, nb = r % 32; transpose_item(A.in[I_WDOWN] + le * DE * D, D, DE, (bf16_t*)(ws + WS_W2) + le * 1024 * 512, 64 * kb, 32 * nb, 32 * nb, scr, F.lane); }
    }
    { const int gt = F.gw * 64 + F.lane, NGT = F.NGW * 64;
      constexpr int ZW = 96 * 1024 * 2 / 16, ZQ = 128 * 256 * 2 / 16;
      for (int i = gt; i < NL * (ZW + ZQ); i += NGT) { const int l = i / (ZW + ZQ), r = i % (ZW + ZQ);
          u32x4* p = r < ZW ? (u32x4*)(ws + WS_WIN + ((size_t)l * ZP + ZC) * D * 2) + r : (u32x4*)(ws + WS_WUQ + ((size_t)l * 512 + 384) * 256 * 2) + (r - ZW);
          *p = (u32x4){0u, 0u, 0u, 0u}; }
      for (int i = gt; i < NL * 4 * 128 * 16; i += NGT) { const int ch = i & 15, row = i >> 4; const int s = ch >> 1, hi = ch & 1;
          const float* src = A.in[I_SGW] + (size_t)row * 128 + 16 * s + 4 * hi;
          u32x4 o; o.x = pk2(src[0], src[1]); o.y = pk2(src[2], src[3]); o.z = pk2(src[8], src[9]); o.w = pk2(src[10], src[11]);
          *((u32x4*)(ws + WS_SGW) + i) = o; }
      for (int i = gt; i < SEQ * 16; i += NGT) { const int t = i >> 4, p = i & 15;
          const float pos = (p < 8) ? (float)(t >> 6) : (float)(t & 63);
          const float ang = pos * powf(10000.f, -(float)(p & 7) / 8.f);
          ((f32x2*)(ws + WS_ROPE))[i] = (f32x2){cosf(ang), sinf(ang)}; }
      for (int i = gt; i < NL * 36 * 1024; i += NGT) { const int k = i & 1023, j = (i >> 10) % 36, l = i / (36 * 1024);
          ((float*)(ws + WS_RW))[i] = j < 4 ? A.in[I_WGRP][((size_t)l * D + k) * 4 + j] : A.in[I_WEXP][((size_t)l * D + k) * 32 + (j - 4)]; }
    }
    __syncthreads();
    { LAS float* red = (LAS float*)(F.lds + 8 * 8448);
      for (int it = F.vcu; it < NL * 96; it += F.G) { const int l = it / 96, col = (it % 96) * 64 + F.lane;
          const float* w = A.in[I_WADA] + (size_t)l * D * 6144 + col;
          float a0 = 0.f, a1 = 0.f, a2 = 0.f, a3 = 0.f, a4 = 0.f;
          const int kb = F.wave * 128;
#pragma unroll 16
          for (int k = 0; k < 128; ++k) { const float wv = w[(size_t)(kb + k) * 6144];
              a0 += silu_f(A.in[I_C][kb + k]) * wv; a1 += silu_f(A.in[I_C][D + kb + k]) * wv; a2 += silu_f(A.in[I_C][2 * D + kb + k]) * wv; a3 += silu_f(A.in[I_C][3 * D + kb + k]) * wv; a4 += silu_f(A.in[I_CCTX][kb + k]) * wv; }
          red[(F.wave * 5 + 0) * 64 + F.lane] = a0; red[(F.wave * 5 + 1) * 64 + F.lane] = a1; red[(F.wave * 5 + 2) * 64 + F.lane] = a2; red[(F.wave * 5 + 3) * 64 + F.lane] = a3; red[(F.wave * 5 + 4) * 64 + F.lane] = a4;
          __syncthreads();
          if (F.tid < 320) { const int bb = F.tid >> 6, ln = F.tid & 63; float s = 0.f;
#pragma unroll
              for (int wv = 0; wv < 8; ++wv) s += red[(wv * 5 + bb) * 64 + ln];
              const int cc = (it % 96) * 64 + ln;
              ((float*)(ws + WS_MOD))[((size_t)l * 5 + bb) * 6144 + cc] = s + A.in[I_BADA][l * 6144 + cc]; }
          __syncthreads(); }
    }
}

__device__ __forceinline__ void moe_tables(Frame& F, const Args& A, int l) {
    LAS int* tb = (LAS int*)(F.lds + LDS_MOE); LAS int* cn = tb + 64;
    __syncthreads();
    if (F.tid == 0) { const int* cnt = (const int*)(F.ws + WS_CTL) + CW_CNT + l * NE * 64; int acc = 0;
        for (int e = 0; e < NE; ++e) { const int c = __hip_atomic_load(cnt + e * 64, __ATOMIC_RELAXED, __HIP_MEMORY_SCOPE_AGENT); tb[e] = acc; cn[e] = c; acc += (c + 255) >> 8; }
        tb[32] = acc; }
    __syncthreads();
}

template <int U>
__device__ __forceinline__ void load_x_rows(Frame& F, const Args& A, int r0, bool from_input, int lp, f32x4 (&x)[U][4], bool write_back) {
#pragma unroll
    for (int u = 0; u < U; ++u) { const int r = r0 + u;
        const float* xr;
        if (from_input) xr = r < NLAT ? A.in[I_X] + (size_t)r * D : A.in[I_CTX] + (size_t)(r - NLAT) * D;
        else xr = r < NLAT ? F.out + (size_t)r * D : (const float*)(F.ws + WS_XC) + (size_t)(r - NLAT) * D;
#pragma unroll
        for (int i = 0; i < 4; ++i) x[u][i] = *(const f32x4*)(xr + 4 * F.lane + 256 * i); }
    if (lp >= 0) {
        const LAS int* tb = (const LAS int*)(F.lds + LDS_MOE);
        const int* asg = (const int*)(F.ws + WS_ASG); const float* gate = (const float*)(F.ws + WS_GATE);
        typedef int i32x4 __attribute__((ext_vector_type(4)));
        i32x4 as[U]; f32x2 gt[U];
#pragma unroll
        for (int u = 0; u < U; ++u) { as[u] = *(const i32x4*)(asg + 4 * (r0 + u)); gt[u] = *(const f32x2*)(gate + 2 * (r0 + u)); }
        u32x2 ya[U][4], yb[U][4];
#pragma unroll
        for (int u = 0; u < U; ++u) {
            const bf16_t* y0 = (const bf16_t*)(F.ws + WS_Y) + (size_t)(tb[as[u][0]] * 256 + as[u][1]) * D; const bf16_t* y1 = (const bf16_t*)(F.ws + WS_Y) + (size_t)(tb[as[u][2]] * 256 + as[u][3]) * D;
#pragma unroll
            for (int i = 0; i < 4; ++i) { ya[u][i] = *(const u32x2*)(y0 + 4 * F.lane + 256 * i); yb[u][i] = *(const u32x2*)(y1 + 4 * F.lane + 256 * i); } }
        const float* g2 = (const float*)(F.ws + WS_MOD) + ((size_t)lp * 5 + mod_idx(r0)) * 6144 + 5120;
#pragma unroll
        for (int i = 0; i < 4; ++i) { const int c = 4 * F.lane + 256 * i; const f32x4 gg = *(const f32x4*)(g2 + c);
#pragma unroll
            for (int u = 0; u < U; ++u) { const int r = r0 + u; const float g0 = gt[u][0], g1 = gt[u][1]; const u32x2 a = ya[u][i], b = yb[u][i];
                x[u][i][0] += gg[0] * (g0 * bf_lo(a.x) + g1 * bf_lo(b.x)); x[u][i][1] += gg[1] * (g0 * bf_hi(a.x) + g1 * bf_hi(b.x));
                x[u][i][2] += gg[2] * (g0 * bf_lo(a.y) + g1 * bf_lo(b.y)); x[u][i][3] += gg[3] * (g0 * bf_hi(a.y) + g1 * bf_hi(b.y));
                if (write_back) { float* xw = r < NLAT ? F.out + (size_t)r * D : (float*)(F.ws + WS_XC) + (size_t)(r - NLAT) * D; *(f32x4*)(xw + c) = x[u][i]; } } }
    }
}
__device__ __forceinline__ float row_rs(const f32x4 (&x)[4], int lane) {
    float ss = 0.f;
#pragma unroll
    for (int i = 0; i < 4; ++i) ss += (x[i][0] * x[i][0] + x[i][1] * x[i][1]) + (x[i][2] * x[i][2] + x[i][3] * x[i][3]);
    return 1.0f / sqrtf(wave_sum(ss, lane) * (1.f / D) + EPS);
}

template <bool DRY>
__device__ __forceinline__ void phase_norm1(Frame& F, const Args& A, int l) {
    if (l > 0) moe_tables(F, A, l - 1);
    const float* g = A.in[I_N1G] + l * D;
    constexpr int U = 2;
    for (int r0 = F.gw * U; r0 < MT; r0 += F.NGW * U) {
        f32x4 x[U][4]; load_x_rows<U>(F, A, r0, l == 0, l - 1, x, !DRY);
        float rs[U];
#pragma unroll
        for (int u = 0; u < U; ++u) rs[u] = row_rs(x[u], F.lane);
        const float* m = (const float*)(F.ws + WS_MOD) + ((size_t)l * 5 + mod_idx(r0)) * 6144;
#pragma unroll
        for (int i = 0; i < 4; ++i) { const int c = 4 * F.lane + 256 * i; const f32x4 gv = *(const f32x4*)(g + c), sc = *(const f32x4*)(m + 1024 + c), sh = *(const f32x4*)(m + c);
#pragma unroll
            for (int u = 0; u < U; ++u) { const f32x4 o = x[u][i] * rs[u] * gv * (sc + 1.f) + sh; u32x2 w; w.x = pk2(o[0], o[1]); w.y = pk2(o[2], o[3]); *(u32x2*)((bf16_t*)(F.ws + WS_HB) + (size_t)(r0 + u) * D + c) = w; } }
    }
}
__device__ __forceinline__ void phase_final(Frame& F, const Args& A) {
    moe_tables(F, A, NL - 1);
    const float* g = A.in[I_FNG];
    constexpr int U = 2;
    for (int r0 = F.gw * U; r0 < NLAT; r0 += F.NGW * U) {
        f32x4 x[U][4]; load_x_rows<U>(F, A, r0, false, NL - 1, x, false);
        float rs[U];
#pragma unroll
        for (int u = 0; u < U; ++u) rs[u] = row_rs(x[u], F.lane);
#pragma unroll
        for (int i = 0; i < 4; ++i) { const int c = 4 * F.lane + 256 * i; const f32x4 gv = *(const f32x4*)(g + c);
#pragma unroll
            for (int u = 0; u < U; ++u) *(f32x4*)(F.out + (size_t)(r0 + u) * D + c) = x[u][i] * rs[u] * gv; }
    }
}

__device__ __forceinline__ void phase_conv(Frame& F, const Args& A, int l) {
    const bf16_t* Z = (const bf16_t*)(F.ws + WS_Z); bf16_t* YC = (bf16_t*)(F.ws + WS_YC);
    const float* cw = A.in[I_CONVW] + l * 768;
    const int nrow = (l < NL - 1) ? MT : NLAT; int extra = nrow / 128 - F.G; extra = (extra > 0 && extra < F.G) ? extra : 0;
    if (F.vcu < extra) return;
    for (int it = (F.vcu - extra) * 512 + F.tid; it < nrow * 32; it += (F.G - extra) * 512) {
        const int r = it >> 5, cg = (it & 31) * 8;
        int t, n; if (r < NLAT) { t = r & 8191; n = SEQ; } else { t = (r - NLAT) & 255; n = CTX; }
        float acc[8] = {0.f, 0.f, 0.f, 0.f, 0.f, 0.f, 0.f, 0.f};
#pragma unroll
        for (int k = 0; k < 3; ++k) { const int tt = t + k - 1;
            if (tt >= 0 && tt < n) { const bf16_t* z = Z + (size_t)(r + k - 1) * ZP; const u32x4 c = *(const u32x4*)(z + 256 + cg), hx = *(const u32x4*)(z + 512 + cg);
                const f32x4 w0 = *(const f32x4*)(cw + k * 256 + cg), w1 = *(const f32x4*)(cw + k * 256 + cg + 4);
                acc[0] += bf_lo(c.x) * bf_lo(hx.x) * w0[0]; acc[1] += bf_hi(c.x) * bf_hi(hx.x) * w0[1]; acc[2] += bf_lo(c.y) * bf_lo(hx.y) * w0[2]; acc[3] += bf_hi(c.y) * bf_hi(hx.y) * w0[3];
                acc[4] += bf_lo(c.z) * bf_lo(hx.z) * w1[0]; acc[5] += bf_hi(c.z) * bf_hi(hx.z) * w1[1]; acc[6] += bf_lo(c.w) * bf_lo(hx.w) * w1[2]; acc[7] += bf_hi(c.w) * bf_hi(hx.w) * w1[3]; } }
        const u32x4 bg = *(const u32x4*)(Z + (size_t)r * ZP + cg);
        u32x4 o; o.x = pk2(bf_lo(bg.x) * acc[0], bf_hi(bg.x) * acc[1]); o.y = pk2(bf_lo(bg.y) * acc[2], bf_hi(bg.y) * acc[3]); o.z = pk2(bf_lo(bg.z) * acc[4], bf_hi(bg.z) * acc[5]); o.w = pk2(bf_lo(bg.w) * acc[6], bf_hi(bg.w) * acc[7]);
        *(u32x4*)(YC + (size_t)r * D + cg) = o;
    }
}

__device__ __forceinline__ void phase_sg(Frame& F, const Args& A, int l) {
    const bf16_t* Z = (const bf16_t*)(F.ws + WS_Z); bf16_t* YC = (bf16_t*)(F.ws + WS_YC);
    LAS unsigned char* vt = F.lds;
    LAS float* red = (LAS float*)(F.lds + 65536);
    const int lane = F.lane, r32 = lane & 31, hi = lane >> 5, w = F.wave, h = w >> 1, pb = w & 1;
    for (int ch = F.vcu; ch < ((l < NL - 1) ? MT : NLAT) / 128; ch += F.G) {
        const int r0 = ch * 128;
        { const int tok = F.tid & 127, hq = F.tid >> 7;
          const bf16_t* zv = Z + (size_t)(r0 + tok) * ZP + 1024 + hq * 64;
          float f[64]; float s1 = 0.f;
#pragma unroll
          for (int c8 = 0; c8 < 8; ++c8) { const u32x4 v = *(const u32x4*)(zv + 8 * c8);
              f[8 * c8 + 0] = gelu_tanh(bf_lo(v.x)); f[8 * c8 + 1] = gelu_tanh(bf_hi(v.x)); f[8 * c8 + 2] = gelu_tanh(bf_lo(v.y)); f[8 * c8 + 3] = gelu_tanh(bf_hi(v.y));
              f[8 * c8 + 4] = gelu_tanh(bf_lo(v.z)); f[8 * c8 + 5] = gelu_tanh(bf_hi(v.z)); f[8 * c8 + 6] = gelu_tanh(bf_lo(v.w)); f[8 * c8 + 7] = gelu_tanh(bf_hi(v.w)); }
#pragma unroll
          for (int j = 0; j < 64; ++j) s1 += f[j];
          red[hq * 128 + tok] = s1;
          __syncthreads();
          const float mean = (red[tok] + red[128 + tok] + red[256 + tok] + red[384 + tok]) * (1.f / 256.f);
          float s2 = 0.f;
#pragma unroll
          for (int j = 0; j < 64; ++j) { f[j] -= mean; s2 += f[j] * f[j]; }
          __syncthreads();
          red[hq * 128 + tok] = s2;
          __syncthreads();
          const float rstd = 1.0f / sqrtf((red[tok] + red[128 + tok] + red[256 + tok] + red[384 + tok]) * (1.f / 256.f) + EPS);
          LAS unsigned char* tile = vt + (hq * 2 + (tok >> 6)) * 8192;
#pragma unroll
          for (int d8 = 0; d8 < 8; ++d8) { u32x4 o; o.x = pk2(f[8 * d8] * rstd, f[8 * d8 + 1] * rstd); o.y = pk2(f[8 * d8 + 2] * rstd, f[8 * d8 + 3] * rstd); o.z = pk2(f[8 * d8 + 4] * rstd, f[8 * d8 + 5] * rstd); o.w = pk2(f[8 * d8 + 6] * rstd, f[8 * d8 + 7] * rstd);
              *(LAS u32x4*)(tile + vtile_off(tok & 63, d8)) = o; }
        }
        bf16x8 bfr[2][8];
#pragma unroll
        for (int pn = 0; pn < 2; ++pn)
#pragma unroll
            for (int s = 0; s < 8; ++s) bfr[pn][s] = *(const bf16x8*)(F.ws + WS_SGW + ((((size_t)(l * 4 + h) * 128 + 64 * pb + 32 * pn + r32) * 8 + s) * 2 + hi) * 16);
        __syncthreads();
        f32x16 acc[2][2] = {};
        const LAS unsigned char* vb = vt + h * 16384 + ((lane >> 4) & 1) * 32 + (lane & 3) * 8 + (4 * hi + ((lane & 15) >> 2)) * 64;
#pragma unroll
        for (int s = 0; s < 8; ++s) {
            const LAS unsigned char* p = vb + (s >> 2) * 8192 + (s & 3) * 1024;
            const s16x4 a0l = vtr(p), a0h = vtr(p + 512), a1l = vtr(p + 4096), a1h = vtr(p + 4096 + 512);
            const bf16x8 va0 = {a0l[0], a0l[1], a0l[2], a0l[3], a0h[0], a0h[1], a0h[2], a0h[3]};
            const bf16x8 va1 = {a1l[0], a1l[1], a1l[2], a1l[3], a1h[0], a1h[1], a1h[2], a1h[3]};
#pragma unroll
            for (int pn = 0; pn < 2; ++pn) { acc[0][pn] = __builtin_amdgcn_mfma_f32_32x32x16_bf16(va0, bfr[pn][s], acc[0][pn], 0, 0, 0); acc[1][pn] = __builtin_amdgcn_mfma_f32_32x32x16_bf16(va1, bfr[pn][s], acc[1][pn], 0, 0, 0); }
        }
#pragma unroll
        for (int pn = 0; pn < 2; ++pn) { const int p = 64 * pb + 32 * pn + r32; const int row = r0 + p;
            const float bias = A.in[I_SGB][(l * 4 + h) * 128 + p];
#pragma unroll
            for (int db = 0; db < 2; ++db)
#pragma unroll
                for (int g = 0; g < 4; ++g) { const int d = 32 * db + 8 * g + 4 * hi;
                    const u32x2 uz = *(const u32x2*)(Z + (size_t)row * ZP + 768 + h * 64 + d);
                    const float u0 = gelu_tanh(bf_lo(uz.x)), u1 = gelu_tanh(bf_hi(uz.x)), u2 = gelu_tanh(bf_lo(uz.y)), u3 = gelu_tanh(bf_hi(uz.y));
                    u32x2 o; o.x = pk2(u0 * (acc[db][pn][4 * g] + bias), u1 * (acc[db][pn][4 * g + 1] + bias)); o.y = pk2(u2 * (acc[db][pn][4 * g + 2] + bias), u3 * (acc[db][pn][4 * g + 3] + bias));
                    *(u32x2*)(YC + (size_t)row * D + 256 + h * 64 + d) = o; } }
        __syncthreads();
    }
}

__device__ __forceinline__ void phase_mlaprep(Frame& F, const Args& A, int l) {
    const bf16_t* Z = (const bf16_t*)(F.ws + WS_Z);
    const float* qg = A.in[I_QNG] + l * 256; const float* kg = A.in[I_KVNG] + l * 128;
    const int lane = F.lane, j = lane & 31;
    constexpr int U = 4;
    const f32x4 gq = *(const f32x4*)(qg + 4 * lane); const float kg0 = kg[2 * lane], kg1 = kg[2 * lane + 1];
    for (int r0 = F.gw * U; r0 < MT; r0 += F.NGW * U) {
        u32x2 a[U]; unsigned kvw[U]; bf16_t kr[U]; f32x2 cs[U];
#pragma unroll
        for (int u = 0; u < U; ++u) { const bf16_t* z = Z + (size_t)(r0 + u) * ZP + 2048; a[u] = *(const u32x2*)(z + 4 * lane); kvw[u] = *(const unsigned*)(z + 256 + 2 * lane); kr[u] = z[384 + j];
            cs[u] = (f32x2){1.f, 0.f};
            if (r0 < NLAT) { const int p = (j & 7) + ((j >> 4) << 3); cs[u] = ((const f32x2*)(F.ws + WS_ROPE))[(size_t)((r0 + u) & 8191) * 16 + p]; } }
#pragma unroll
        for (int u = 0; u < U; ++u) { const int r = r0 + u;
            const float q0 = bf_lo(a[u].x), q1 = bf_hi(a[u].x), q2 = bf_lo(a[u].y), q3 = bf_hi(a[u].y);
            const float rsq = 1.0f / sqrtf(wave_sum((q0 * q0 + q1 * q1) + (q2 * q2 + q3 * q3), lane) * (1.f / 256.f) + EPS);
            u32x2 oq; oq.x = pk2(q0 * rsq * gq[0], q1 * rsq * gq[1]); oq.y = pk2(q2 * rsq * gq[2], q3 * rsq * gq[3]);
            *(u32x2*)((bf16_t*)(F.ws + WS_CQN) + (size_t)r * 256 + 4 * lane) = oq;
            const float k0 = bf_lo(kvw[u]), k1 = bf_hi(kvw[u]);
            const float rsk = 1.0f / sqrtf(wave_sum(k0 * k0 + k1 * k1, lane) * (1.f / 128.f) + EPS);
            *(unsigned*)((bf16_t*)(F.ws + WS_CKVN) + (size_t)r * 128 + 2 * lane) = pk2(k0 * rsk * kg0, k1 * rsk * kg1);
            const float xv = bf1(kr[u]);
            const float pv = shx(xv, 8, lane);
            const float o = (j & 8) ? (xv * cs[u].x + pv * cs[u].y) : (xv * cs[u].x - pv * cs[u].y);
            int b, t, kk; tok_tile(r, b, t, kk);
            if (lane < 32) { const bf16_t ob = (bf16_t)f2bf(o);
#pragma unroll
                for (int hh = 0; hh < 4; ++hh) *(bf16_t*)(F.ws + WS_MK + (size_t)((b * 4 + hh) * NTILE + t) * MKB + ktile_off(kk, 8 + (j >> 3)) + (j & 7) * 2) = ob; } }
    }
}

template <bool DRY>
__device__ __forceinline__ void phase_mergenorm(Frame& F, const Args& A, int l) {
    bf16_t* YC = (bf16_t*)(F.ws + WS_YC); bf16_t* YO = DRY ? (bf16_t*)(F.ws + WS_HB) : YC; const float* og = A.in[I_ONG] + l * D;
    constexpr int U = 4;
    f32x4 g[4];
#pragma unroll
    for (int i = 0; i < 4; ++i) g[i] = *(const f32x4*)(og + 4 * F.lane + 256 * i);
    for (int r0 = F.gw * U; r0 < MT; r0 += F.NGW * U) {
        u32x2 a[U][4];
#pragma unroll
        for (int u = 0; u < U; ++u)
#pragma unroll
            for (int i = 0; i < 4; ++i) a[u][i] = *(const u32x2*)(YC + (size_t)(r0 + u) * D + 4 * F.lane + 256 * i);
#pragma unroll
        for (int u = 0; u < U; ++u)
#pragma unroll
            for (int i = 0; i < 4; ++i) { const float v0 = bf_lo(a[u][i].x), v1 = bf_hi(a[u][i].x), v2 = bf_lo(a[u][i].y), v3 = bf_hi(a[u][i].y);
                const float rs = 1.0f / sqrtf(wave_sum((v0 * v0 + v1 * v1) + (v2 * v2 + v3 * v3), F.lane) * (1.f / 256.f) + EPS);
                u32x2 o; o.x = pk2(v0 * rs * g[i][0], v1 * rs * g[i][1]); o.y = pk2(v2 * rs * g[i][2], v3 * rs * g[i][3]); *(u32x2*)(YO + (size_t)(r0 + u) * D + 4 * F.lane + 256 * i) = o; }
    }
}

template <bool DRY>
__device__ __forceinline__ void phase_router(Frame& F, const Args& A, int l) {
    LAS float* rw = (LAS float*)F.lds;
    LAS int* lcnt = (LAS int*)(F.lds + LDS_MISC + 256);
    __syncthreads();
    if (F.tid < 64) lcnt[F.tid] = 0;
    { const f32x4* src = (const f32x4*)((const float*)(F.ws + WS_RW) + (size_t)l * 36 * 1024);
      for (int i = F.tid; i < 36 * 256; i += 512) ((LAS f32x4*)rw)[i] = src[i]; }
    __syncthreads();
    const int nrows = (l < NL - 1) ? MT : NLAT;
    const float* g = A.in[I_N2G] + l * D; const float* bgrp = A.in[I_BGRP] + l * 4; const float* bexp = A.in[I_BEXP] + l * NE;
    int* cnt = (int*)(F.ws + WS_CTL) + CW_CNT + l * NE * 64; int* list = (int*)(F.ws + WS_LIST); int* asg = (int*)(F.ws + WS_ASG); float* gate = (float*)(F.ws + WS_GATE);
    constexpr int U = 2;
    for (int r0 = F.gw * U; r0 < nrows; r0 += F.NGW * U) {
        f32x4 x[U][4]; load_x_rows<U>(F, A, r0, false, -1, x, false);
        float rs[U];
#pragma unroll
        for (int u = 0; u < U; ++u) rs[u] = row_rs(x[u], F.lane);
        const float* m = (const float*)(F.ws + WS_MOD) + ((size_t)l * 5 + mod_idx(r0)) * 6144;
#pragma unroll
        for (int i = 0; i < 4; ++i) { const int c = 4 * F.lane + 256 * i; const f32x4 gv = *(const f32x4*)(g + c), sc = *(const f32x4*)(m + 4096 + c), sh = *(const f32x4*)(m + 3072 + c);
#pragma unroll
            for (int u = 0; u < U; ++u) { x[u][i] = x[u][i] * rs[u] * gv * (sc + 1.f) + sh; u32x2 w; w.x = pk2(x[u][i][0], x[u][i][1]); w.y = pk2(x[u][i][2], x[u][i][3]); *(u32x2*)((bf16_t*)(F.ws + WS_HB) + (size_t)(r0 + u) * D + c) = w; } }
        float lg[U][4];
#pragma unroll
        for (int j = 0; j < 4; ++j) { float a[U];
#pragma unroll
            for (int u = 0; u < U; ++u) a[u] = 0.f;
#pragma unroll
            for (int i = 0; i < 4; ++i) { const f32x4 wv = *(const LAS f32x4*)(rw + j * 1024 + 4 * F.lane + 256 * i);
#pragma unroll
                for (int u = 0; u < U; ++u) a[u] += (x[u][i][0] * wv[0] + x[u][i][1] * wv[1]) + (x[u][i][2] * wv[2] + x[u][i][3] * wv[3]); }
#pragma unroll
            for (int u = 0; u < U; ++u) lg[u][j] = wave_sum(a[u], F.lane) + bgrp[j]; }
#pragma unroll
        for (int u = 0; u < U; ++u) { const int r = r0 + u;
            int gs = 0; float gm = lg[u][0];
#pragma unroll
            for (int j = 1; j < 4; ++j) if (lg[u][j] > gm) { gm = lg[u][j]; gs = j; }
            float se = 0.f;
#pragma unroll
            for (int j = 0; j < 4; ++j) se += __expf(lg[u][j] - gm);
            const float pg = 1.f / se;
            gs = __builtin_amdgcn_readfirstlane(gs);
            float el[8];
#pragma unroll
            for (int j = 0; j < 8; ++j) { float a = 0.f; const LAS float* wr_ = rw + (4 + gs * 8 + j) * 1024;
#pragma unroll
                for (int i = 0; i < 4; ++i) { const f32x4 wv = *(const LAS f32x4*)(wr_ + 4 * F.lane + 256 * i); a += (x[u][i][0] * wv[0] + x[u][i][1] * wv[1]) + (x[u][i][2] * wv[2] + x[u][i][3] * wv[3]); }
                el[j] = wave_sum(a, F.lane) + bexp[gs * 8 + j]; }
            int i1 = 0; float v1 = el[0];
#pragma unroll
            for (int j = 1; j < 8; ++j) if (el[j] > v1) { v1 = el[j]; i1 = j; }
            int i2 = 0; float v2 = -INFINITY;
#pragma unroll
            for (int j = 0; j < 8; ++j) if (j != i1 && el[j] > v2) { v2 = el[j]; i2 = j; }
            const float e2 = __expf(v2 - v1);
            const float w1 = 1.f / (1.f + e2), w2 = e2 / (1.f + e2);
            if (F.lane == 0 && (!DRY || w1 < -1.f)) {
                const int E1 = gs * 8 + i1, E2 = gs * 8 + i2;
                const int p1 = __hip_atomic_fetch_add(lcnt + E1, 1, __ATOMIC_RELAXED, __HIP_MEMORY_SCOPE_WORKGROUP), p2 = __hip_atomic_fetch_add(lcnt + E2, 1, __ATOMIC_RELAXED, __HIP_MEMORY_SCOPE_WORKGROUP);
                typedef int i32x4 __attribute__((ext_vector_type(4)));
                *(i32x4*)(asg + 4 * r) = (i32x4){E1, p1, E2, p2};
                *(f32x2*)(gate + 2 * r) = (f32x2){pg * w1, pg * w2};
            }
        }
    }
    __syncthreads();
    if (!DRY) {
        if (F.tid < NE) { const int c = lcnt[F.tid]; lcnt[32 + F.tid] = c ? atomicAdd(&cnt[F.tid * 64], c) : 0; }
        __syncthreads();
        asm volatile("s_waitcnt vmcnt(0)" ::: "memory");
        for (int r0 = F.gw * U; r0 < nrows; r0 += F.NGW * U) {
            if (F.lane < U) { const int r = r0 + F.lane; typedef int i32x4 __attribute__((ext_vector_type(4)));
                i32x4 a = *(const i32x4*)(asg + 4 * r); a[1] += lcnt[32 + a[0]]; a[3] += lcnt[32 + a[2]];
                *(i32x4*)(asg + 4 * r) = a; list[(size_t)a[0] * MT + a[1]] = r * 2; list[(size_t)a[2] * MT + a[3]] = r * 2 + 1; }
        }
    }
}
__device__ __forceinline__ void frame_ids(Frame& F) {
    { int t = (F.wave0 << 6) | lane_id(); asm volatile("" : "+v"(t)); F.tid = t; } F.lane = F.tid & 63; F.wave = __builtin_amdgcn_readfirstlane(F.tid >> 6);
    int bx = blockIdx.x; asm volatile("" : "+s"(bx));
    F.G = gridDim.x; F.vcu = (bx & 7) * (F.G >> 3) + (bx >> 3); F.bx = bx;
    F.gw = F.vcu * 8 + F.wave; F.NGW = F.G * 8;
}
__device__ __forceinline__ void phase_attn(Frame& F, const Args& A, int l) {
    const unsigned char* ws = F.ws;
    const bf16_t* Z = (const bf16_t*)(ws + WS_Z); const bf16_t* QM = (const bf16_t*)(ws + WS_QM); bf16_t* YC = (bf16_t*)(F.ws + WS_YC);
    LAS float* tab = (LAS float*)(F.lds + 81920);
    const int w = F.wave;
    const int nctx = (l < NL - 1) ? 16 : 0;
    for (int k = F.vcu; k < 512 + nctx; k += F.G) {
        frame_ids(F);
        const int uid = (F.G == 256 && k < 512) ? ((k & 255) * 2 + (k >> 8)) : k;
        NaInfo ni; ni.active_lo = 0; ni.active_hi = -1; ni.qrow = 0; ni.qcol = 0; ni.c0 = 0; ni.tab = tab;
        if (uid < 512) {
            const int b = uid >> 7, h = (uid >> 5) & 3, R0 = (uid & 31) * 4;
            __syncthreads();
            for (int j = F.tid; j < 15 * 128; j += 512) { int ix = (j & 127) - 48; ix = ix < 0 ? 0 : (ix > 30 ? 30 : ix); tab[j] = A.in[I_RPB][(size_t)(l * 4 + h) * 465 + (j >> 7) * 31 + ix] * LOG2E; }
            const int qrow = R0 + (w >> 1), qcol = 32 * (w & 1) + (F.lane & 31);
            const int bs = min(max(qrow - 4, 0), 120);
            ni.active_lo = bs; ni.active_hi = bs + 7; ni.qrow = qrow; ni.qcol = qcol; ni.c0 = min(max(qcol - 8, 0), 48);
            const int U0 = min(max(R0 - 4, 0), 120), U1 = min(max(R0 + 3 - 4, 0), 120) + 7;
            const int q0 = b * SEQ + qrow * 64 + 32 * (w & 1);
            const size_t tb = (size_t)(b * 4 + h) * NTILE;
            attn_unit<4, true, false>(F.lds, F.tid, Z + (size_t)q0 * ZP + 1280 + h * 64, ZP, ws + WS_NK + tb * NKB, ws + WS_NV + tb * VB, U0, U1 - U0 + 1, 4, YC + (size_t)q0 * D + 512 + h * 64, ni, nullptr);
        } else {
            const int cu = uid - 512, b = cu >> 2, h = cu & 3;
            const int q0 = NLAT + b * CTX + 32 * w;
            const size_t tb = (size_t)(b * 4 + h) * NTILE;
            attn_unit<4, false, false>(F.lds, F.tid, Z + (size_t)q0 * ZP + 1280 + h * 64, ZP, ws + WS_NK + tb * NKB, ws + WS_NV + tb * VB, 128, 4, 0, YC + (size_t)q0 * D + 512 + h * 64, ni, nullptr);
        }
    }
    frame_ids(F);
    for (int k = F.vcu; k < 512; k += F.G) {
        frame_ids(F);
        const int uid = (F.G == 256) ? ((k & 255) * 2 + (k >> 8)) : k;
        NaInfo ni; ni.active_lo = 0; ni.active_hi = -1; ni.qrow = 0; ni.qcol = 0; ni.c0 = 0; ni.tab = tab;
        const int b = uid >> 7, h = (uid >> 5) & 3, qb = uid & 31;
        const int q0 = b * SEQ + qb * 256 + 32 * w;
        const size_t tb = (size_t)(b * 4 + h) * NTILE;
        attn_unit<6, false, true>(F.lds, F.tid, QM + (size_t)q0 * 384 + h * 96, 384, ws + WS_MK + tb * MKB, ws + WS_MV + tb * VB, 0, NTILE, 0, YC + (size_t)q0 * D + 768 + h * 64, ni, (const float*)(ws + WS_ROPE) + (size_t)(q0 & 8191) * 32);
    }
    frame_ids(F);
    const int vs = (F.G >= 32) ? F.vcu - 16 : F.vcu;
    for (int cu = vs; cu >= 0 && cu < nctx; cu += F.G) {
        frame_ids(F);
        NaInfo ni; ni.active_lo = 0; ni.active_hi = -1; ni.qrow = 0; ni.qcol = 0; ni.c0 = 0; ni.tab = tab;
        const int b = cu >> 2, h = cu & 3;
        const int q0 = NLAT + b * CTX + 32 * w;
        const size_t tb = (size_t)(b * 4 + h) * NTILE;
        attn_unit<6, false, false>(F.lds, F.tid, QM + (size_t)q0 * 384 + h * 96, 384, ws + WS_MK + tb * MKB, ws + WS_MV + tb * VB, 128, 4, 0, YC + (size_t)q0 * D + 768 + h * 64, ni, nullptr);
    }
}

__device__ __forceinline__ void outproj_ctx(Frame& F, const bf16_t* YC, const bf16_t* Bt, const float* res, float* xo, const float* g1c) {
    for (int t = F.vcu; t < 256; t += F.G) {
        const int tr = t >> 4, tc = t & 15, fr = F.lane & 15, fq = F.lane >> 4;
        const int r = tr * 64 + (F.wave >> 1) * 16 + fr, n0 = tc * 64 + (F.wave & 1) * 32;
        const bf16_t* ap = YC + (size_t)(NLAT + r) * D + 8 * fq;
        const bf16_t* bp0 = Bt + (size_t)(n0 + fr) * D + 8 * fq;
        const bf16_t* bp1 = bp0 + (size_t)16 * D;
        f32x4 c0 = {0.f, 0.f, 0.f, 0.f}, c1 = {0.f, 0.f, 0.f, 0.f};
#pragma unroll 4
        for (int k = 0; k < D; k += 32) {
            const bf16x8 a = *(const bf16x8*)(ap + k), b0 = *(const bf16x8*)(bp0 + k), b1 = *(const bf16x8*)(bp1 + k);
            c0 = __builtin_amdgcn_mfma_f32_16x16x32_bf16(b0, a, c0, 0, 0, 0);
            c1 = __builtin_amdgcn_mfma_f32_16x16x32_bf16(b1, a, c1, 0, 0, 0);
        }
        const size_t off = (size_t)r * D + n0 + 4 * fq;
        const f32x4 g0 = *(const f32x4*)(g1c + n0 + 4 * fq), g1 = *(const f32x4*)(g1c + n0 + 16 + 4 * fq);
        const f32x4 r0 = *(const f32x4*)(res + off), r1 = *(const f32x4*)(res + off + 16);
        *(f32x4*)(xo + off) = r0 + g0 * c0; *(f32x4*)(xo + off + 16) = r1 + g1 * c1;
    }
}

__global__ void __launch_bounds__(512, 2) fwd(Args args) {
    extern __shared__ __attribute__((aligned(16))) unsigned char lds_raw[];
    Frame F;
    F.lds = (LAS unsigned char*)lds_raw; F.ws = args.ws; F.out = args.out;
    F.wave0 = __builtin_amdgcn_readfirstlane((int)threadIdx.x >> 6);
    frame_ids(F);
    volatile LAS unsigned* MISC = (volatile LAS unsigned*)(F.lds + LDS_MISC);
    if (F.tid < 64) MISC[F.tid] = 0u;
    __syncthreads();
    XcdBarrier bar; bar.bar = (unsigned*)(args.ws + WS_CTL) + CW_BAR; bar.x = 0; bar.st = nullptr;
    if (args.flags & 4) bar = xcd_barrier_post((unsigned*)(args.ws + WS_CTL) + CW_BAR, MISC + 8, F.tid);
#define GRID_BAR() do { if (args.flags & 4) xcd_barrier(bar, (F.wave0 << 6) | lane_id()); } while (0)
#ifndef DUP_MASK
#define DUP_MASK 0
#endif
#define REP(k) for (int rep_ = 0; rep_ < (((DUP_MASK >> (k)) & 1) ? 2 : 1); ++rep_)
#ifndef PHASE_MASK
#define PHASE_MASK 0xFFFF
#endif
#define IN(k) (((PHASE_MASK >> (k)) & 1) && args.ph_lo <= (k) && (k) < args.ph_hi)
#ifdef TS_PHASE
#ifndef TS_Q
#define TS_Q 250.f
#endif
#ifndef TS_OFF
#define TS_OFF 0
#endif
    const unsigned long long ts0_ = __builtin_amdgcn_s_memrealtime();
    float ts_us_ = 0.f;
#define TS_MARK(ph, lay) do { if ((ph) == TS_PHASE && (lay) == TS_LAYER) { const float t_ = (float)(__builtin_amdgcn_s_memrealtime() - ts0_) * 0.01f + (float)TS_OFF; ts_us_ = floorf(t_ * (1.f / TS_Q)) * TS_Q + 0.5f * TS_Q; } } while (0)
#else
#define TS_MARK(ph, lay) do {} while (0)
#endif
    if ((PHASE_MASK & 1) && (args.flags & 1)) REP(0) { frame_ids(F); phase_prologue(F, args); GRID_BAR(); }
    TS_MARK(0, 0);
#define LAUNDER() GAS unsigned char* wsg_ = (GAS unsigned char*)args.ws; asm volatile("" : "+s"(wsg_)); unsigned char* ws = (unsigned char*)wsg_; int l = l_; asm volatile("" : "+s"(l)); F.ws = ws; frame_ids(F)
    for (int l_ = args.l_lo; l_ < args.l_hi; ++l_) {
#if (DUP_MASK >> 1) & 1
        if (IN(1)) { LAUNDER(); phase_norm1<true>(F, args, l); GRID_BAR(); }
#endif
        if (IN(1)) { LAUNDER(); phase_norm1<false>(F, args, l); GRID_BAR(); }
        TS_MARK(1, l_);
        if (IN(2)) REP(2) { LAUNDER();
            pg8::Gemm g{(const bf16_t*)(ws + WS_HB), (const bf16_t*)(ws + WS_WIN) + (size_t)l * ZP * D, D, D};
            pg8::StaticOrder S; S.init(MT, ZP, F.G, F.bx); pg8::PlainRows AR{D * 2};
            EpiZ E{(bf16_t*)(ws + WS_Z), ws + WS_NK, ws + WS_NV};
            pg8::gemm_phase<EpiZ, pg8::StaticOrder, pg8::PlainRows, true, true>(F.lds, F.tid, g, S, AR, E);
            GRID_BAR();
        }
        TS_MARK(2, l_);
#if (DUP_MASK >> 3) & 1
        if (IN(3)) { { LAUNDER(); phase_conv(F, args, l); __syncthreads(); frame_ids(F); phase_sg(F, args, l); __syncthreads(); frame_ids(F); phase_mlaprep(F, args, l); GRID_BAR(); }
                     { LAUNDER(); phase_conv(F, args, l); __syncthreads(); frame_ids(F); phase_sg(F, args, l); __syncthreads(); frame_ids(F); phase_mlaprep(F, args, l); GRID_BAR(); } }
#else
        if (IN(3)) { LAUNDER(); phase_conv(F, args, l); __syncthreads(); frame_ids(F); phase_sg(F, args, l); __syncthreads(); frame_ids(F); phase_mlaprep(F, args, l); GRID_BAR(); }
#endif
        TS_MARK(3, l_);
        if (IN(4)) REP(4) { LAUNDER();
            { pg8::Gemm g{(const bf16_t*)(ws + WS_CQN), (const bf16_t*)(ws + WS_WUQ) + (size_t)l * 512 * 256, 256, 256};
              pg8::StaticOrder S; S.init(MT, 512, F.G, F.bx); pg8::PlainRows AR{256 * 2};
              EpiQ E{(bf16_t*)(ws + WS_QM)};
              pg8::gemm_phase<EpiQ, pg8::StaticOrder, pg8::PlainRows, true, true>(F.lds, F.tid, g, S, AR, E); }
            frame_ids(F);
            { pg8::Gemm g{(const bf16_t*)(ws + WS_CKVN), (const bf16_t*)(ws + WS_WUKV) + (size_t)l * 512 * 128, 128, 128};
              pg8::StaticOrder S; S.init(MT, 512, F.G, (F.G - 1 - F.bx)); pg8::PlainRows AR{128 * 2};
              EpiKV E{ws + WS_MK, ws + WS_MV};
              pg8::gemm_phase<EpiKV, pg8::StaticOrder, pg8::PlainRows, true, true>(F.lds, F.tid, g, S, AR, E); }
            GRID_BAR();
        }
        TS_MARK(4, l_);
#if (DUP_MASK >> 5) & 1
        if (IN(5)) { { LAUNDER(); phase_attn(F, args, l); GRID_BAR(); } { LAUNDER(); phase_attn(F, args, l); GRID_BAR(); } }
#else
        if (IN(5)) { LAUNDER(); phase_attn(F, args, l); GRID_BAR(); }
#endif
        TS_MARK(5, l_);
#if (DUP_MASK >> 6) & 1
        if (IN(6)) { LAUNDER(); phase_mergenorm<true>(F, args, l); GRID_BAR(); }
#endif
        if (IN(6)) { LAUNDER(); phase_mergenorm<false>(F, args, l); GRID_BAR(); }
        TS_MARK(6, l_);
#if (DUP_MASK >> 7) & 1
        if (IN(7)) { LAUNDER();
            pg8::Gemm g{(const bf16_t*)(ws + WS_YC), (const bf16_t*)(ws + WS_WOUT) + (size_t)l * D * D, D, D};
            pg8::StaticOrder S; S.init(MT, D, F.G, F.bx); pg8::PlainRows AR{D * 2};
            EpiOut E{l == 0 ? args.in[I_X] : args.out, l == 0 ? args.in[I_CTX] : (const float*)(ws + WS_XC), (float*)(ws + WS_Z), (float*)(ws + WS_Z) + (size_t)NLAT * D, (const float*)(ws + WS_MOD) + (size_t)l * 5 * 6144 + 2048};
            pg8::gemm_phase<EpiOut, pg8::StaticOrder, pg8::PlainRows, true, true>(F.lds, F.tid, g, S, AR, E);
            GRID_BAR();
        }
#endif
        if (IN(7)) { LAUNDER();
            pg8::Gemm g{(const bf16_t*)(ws + WS_YC), (const bf16_t*)(ws + WS_WOUT) + (size_t)l * D * D, D, D};
            pg8::StaticOrder S; S.init(NLAT, D, F.G, F.bx); pg8::PlainRows AR{D * 2};
            EpiOut E{l == 0 ? args.in[I_X] : args.out, l == 0 ? args.in[I_CTX] : (const float*)(ws + WS_XC), args.out, (float*)(ws + WS_XC), (const float*)(ws + WS_MOD) + (size_t)l * 5 * 6144 + 2048};
            pg8::gemm_phase<EpiOut, pg8::StaticOrder, pg8::PlainRows, true, true>(F.lds, F.tid, g, S, AR, E);
            if (l < NL - 1) { LAUNDER(); outproj_ctx(F, (const bf16_t*)(ws + WS_YC), (const bf16_t*)(ws + WS_WOUT) + (size_t)l * D * D, l == 0 ? args.in[I_CTX] : (const float*)(ws + WS_XC), (float*)(ws + WS_XC), (const float*)(ws + WS_MOD) + (size_t)l * 5 * 6144 + 2048 + 4 * 6144); }
            GRID_BAR();
        }
        TS_MARK(7, l_);
#if (DUP_MASK >> 8) & 1
        if (IN(8)) { LAUNDER(); phase_router<true>(F, args, l); GRID_BAR(); }
#endif
        if (IN(8)) { LAUNDER(); phase_router<false>(F, args, l); GRID_BAR(); }
        TS_MARK(8, l_);
        if (IN(9)) REP(9) { LAUNDER();
            moe_tables(F, args, l);
            const LAS int* tb = (const LAS int*)(F.lds + LDS_MOE);
            pg8::Gemm g{(const bf16_t*)(ws + WS_HB), (const bf16_t*)(ws + WS_W1) + (size_t)l * NE * 1024 * 1024, D, D};
            MoeOrder S{tb, F.G, F.bx}; MoeRows1 AR{D * 2, tb, tb + 64, (const int*)(ws + WS_LIST)};
            EpiMoe1 E{(bf16_t*)(ws + WS_H1)};
            pg8::gemm_phase<EpiMoe1, MoeOrder, MoeRows1, true, true>(F.lds, F.tid, g, S, AR, E);
            GRID_BAR();
        }
        TS_MARK(9, l_);
        if (IN(10)) REP(10) { LAUNDER();
            moe_tables(F, args, l);
            const LAS int* tb = (const LAS int*)(F.lds + LDS_MOE);
            pg8::Gemm g{(const bf16_t*)(ws + WS_H1), (const bf16_t*)(ws + WS_W2) + (size_t)l * NE * 1024 * 512, DE, DE};
            MoeOrder S{tb, F.G, F.bx}; pg8::PlainRows AR{DE * 2};
            EpiMoe2 E{(bf16_t*)(ws + WS_Y)};
            pg8::gemm_phase<EpiMoe2, MoeOrder, pg8::PlainRows, true, true>(F.lds, F.tid, g, S, AR, E);
            GRID_BAR();
        }
        TS_MARK(10, l_);
    }
    if (((PHASE_MASK >> 11) & 1) && (args.flags & 2)) { frame_ids(F); phase_final(F, args); }
#ifdef TS_PHASE
    TS_MARK(11, 0);
    if (blockIdx.x == 0) { __syncthreads(); asm volatile("s_waitcnt vmcnt(0)" ::: "memory"); if (F.tid == 0) args.out[0] = ts_us_; }
#endif
#undef IN
#undef GRID_BAR
}
}

#ifndef MK_ONE_LAUNCH
#define MK_ONE_LAUNCH 1
#endif
extern "C" void kernel_launch(void* const* d_in, const int* in_sizes, int n_in, void* d_out, int out_size, void* d_ws, size_t ws_size, hipStream_t stream) {
    using namespace mk;
    static int grid = 0;
    if (grid == 0) {
        if (n_in != 27 || ws_size < WS_END) { fprintf(stderr, "kernel_launch: unexpected inputs (n_in %d, ws %zu)\n", n_in, ws_size); grid = -1; return; }
        int dev = 0, cus = 0;
        if (hipGetDevice(&dev) != hipSuccess || hipDeviceGetAttribute(&cus, hipDeviceAttributeMultiprocessorCount, dev) != hipSuccess) { grid = -1; return; }
        if (hipFuncSetAttribute((const void*)fwd, hipFuncAttributeMaxDynamicSharedMemorySize, LDS_BYTES) != hipSuccess) { fprintf(stderr, "kernel_launch: hipFuncSetAttribute failed\n"); grid = -1; return; }
        int per_cu = 0;
        if (hipOccupancyMaxActiveBlocksPerMultiprocessor(&per_cu, (const void*)fwd, 512, LDS_BYTES) != hipSuccess || per_cu < 1) fprintf(stderr, "kernel_launch: occupancy query says %d\n", per_cu);
        (void)hipGetLastError();
        grid = cus & ~7;
    }
    if (grid < 0) return;
    if (hipMemsetAsync((char*)d_ws + WS_CTL, 0, CTL_BYTES, stream) != hipSuccess) return;
    Args a; memset(&a, 0, sizeof(a));
    for (int i = 0; i < 27; ++i) a.in[i] = (const float*)d_in[i];
    a.out = (float*)d_out; a.ws = (unsigned char*)d_ws;
#if MK_ONE_LAUNCH
    a.l_lo = 0; a.l_hi = NL; a.ph_lo = 1; a.ph_hi = 11; a.flags = 1 | 2 | 4;
    hipLaunchKernelGGL(fwd, dim3(grid), dim3(512), LDS_BYTES, stream, a);
#else
    a.l_lo = 0; a.l_hi = 0; a.ph_lo = 0; a.ph_hi = 0; a.flags = 1;
    hipLaunchKernelGGL(fwd, dim3(grid), dim3(512), LDS_BYTES, stream, a);
    for (int l = 0; l < NL; ++l)
        for (int ph = 1; ph <= 10; ++ph) { a.l_lo = l; a.l_hi = l + 1; a.ph_lo = ph; a.ph_hi = ph + 1; a.flags = 0; hipLaunchKernelGGL(fwd, dim3(grid), dim3(512), LDS_BYTES, stream, a); }
    a.l_lo = 0; a.l_hi = 0; a.ph_lo = 0; a.ph_hi = 0; a.flags = 2;
    hipLaunchKernelGGL(fwd, dim3(grid), dim3(512), LDS_BYTES, stream, a);
#endif
}
```

```cpp
#define MK_ONE_LAUNCH 1
#include <hip/hip_runtime.h>
#include <stdint.h>
#include <string.h>
#include <stdio.h>

#define LAS __attribute__((address_space(3)))
#define GAS __attribute__((address_space(1)))
typedef unsigned short bf16_t;
typedef short bf16x8 __attribute__((ext_vector_type(8)));
typedef short s16x4 __attribute__((ext_vector_type(4)));
typedef float f32x4 __attribute__((ext_vector_type(4)));
typedef float f32x2 __attribute__((ext_vector_type(2)));
typedef float f32x16 __attribute__((ext_vector_type(16)));
typedef unsigned u32x4 __attribute__((ext_vector_type(4)));
typedef unsigned u32x2 __attribute__((ext_vector_type(2)));
typedef __bf16 bf16x2_t __attribute__((ext_vector_type(2)));

namespace mk {
constexpr int D = 1024, NB = 4, SEQ = 8192, NL = 4, CTX = 256, NLAT = NB * SEQ, NCTX = NB * CTX, MT = NLAT + NCTX;
constexpr int ZC = 2464, ZP = 2560;
constexpr int NE = 32, DE = 512;
constexpr int NTILE = 132;
constexpr int SLOT_TILES = 296, SLOT_ROWS = SLOT_TILES * 256;
constexpr float EPS = 1e-6f;
constexpr float LOG2E = 1.4426950408889634f;
constexpr float MLA_QSCALE = 0.10206207261596577f * LOG2E;
constexpr float NA_QSCALE = 0.125f * LOG2E;
constexpr int MKB = 12288, NKB = 8192, VB = 8192;

constexpr size_t MiB = 1u << 20;
constexpr size_t WS_CTL = 0, CTL_BYTES = 1 * MiB;
constexpr size_t WS_MOD = 1 * MiB;
constexpr size_t WS_ROPE = 2 * MiB;
constexpr size_t WS_RW = 3 * MiB;
constexpr size_t WS_CONV = 4 * MiB;
constexpr size_t WS_WIN = 5 * MiB;
constexpr size_t WS_WOUT = 25 * MiB;
constexpr size_t WS_WUQ = 33 * MiB;
constexpr size_t WS_WUKV = 34 * MiB;
constexpr size_t WS_SGW = 35 * MiB;
constexpr size_t WS_W1 = 36 * MiB;
constexpr size_t WS_W2 = 292 * MiB;
constexpr size_t WS_XC = 420 * MiB;
constexpr size_t WS_HB = 424 * MiB;
constexpr size_t WS_Z = 490 * MiB;
constexpr size_t WS_YC = 655 * MiB;
constexpr size_t WS_H1 = WS_Z;
constexpr size_t WS_Y = WS_Z + 74 * MiB;
constexpr size_t WS_CQN = 721 * MiB;
constexpr size_t WS_CKVN = 738 * MiB;
constexpr size_t WS_QM = 747 * MiB;
constexpr size_t WS_MK = 772 * MiB;
constexpr size_t WS_MV = 797 * MiB;
constexpr size_t WS_NK = 814 * MiB;
constexpr size_t WS_NV = 831 * MiB;
constexpr size_t WS_LIST = 848 * MiB;
constexpr size_t WS_ASG = 853 * MiB;
constexpr size_t WS_GATE = 854 * MiB;
constexpr size_t WS_END = 855 * MiB;
static_assert(WS_H1 + (size_t)SLOT_ROWS * 512 * 2 <= WS_Y && WS_Y + (size_t)SLOT_ROWS * 1024 * 2 <= WS_CQN, "moe overlay");
static_assert(WS_Z + (size_t)MT * ZP * 2 <= WS_YC && WS_YC + (size_t)MT * D * 2 <= WS_CQN, "z/yc");
constexpr int CW_BAR = 4096;
constexpr int CW_CNT = 8192;
constexpr int LDS_SCRATCH = 147456;
constexpr int LDS_MOE = 131072;
constexpr int LDS_MISC = 147456;
constexpr int LDS_BYTES = 163840;

__device__ __forceinline__ unsigned f2bf(float f) { unsigned u = __builtin_bit_cast(unsigned, f); return (u + 0x7fffu + ((u >> 16) & 1u)) >> 16; }
__device__ __forceinline__ unsigned pk2(float lo, float hi) { f32x2 v = {lo, hi}; bf16x2_t b = __builtin_convertvector(v, bf16x2_t); return __builtin_bit_cast(unsigned, b); }
__device__ __forceinline__ float bf_lo(unsigned w) { return __builtin_bit_cast(float, w << 16); }
__device__ __forceinline__ float bf_hi(unsigned w) { return __builtin_bit_cast(float, w & 0xffff0000u); }
__device__ __forceinline__ float bf1(bf16_t h) { return __builtin_bit_cast(float, (unsigned)h << 16); }
__device__ __forceinline__ float shx(float v, int o, int lane) { return __builtin_bit_cast(float, __builtin_amdgcn_ds_bpermute((lane ^ o) << 2, __builtin_bit_cast(int, v))); }
__device__ __forceinline__ unsigned shxu(unsigned v, int o, int lane) { return (unsigned)__builtin_amdgcn_ds_bpermute((lane ^ o) << 2, (int)v); }
__device__ __forceinline__ float dpp_f(float v, const int ctrl) { return v; }
#define DPPADD(v, ctrl) ((v) + __builtin_bit_cast(float, __builtin_amdgcn_update_dpp(0, __builtin_bit_cast(int, (v)), (ctrl), 0xf, 0xf, true)))
__device__ __forceinline__ float wave_sum(float v, int lane) {
    (void)lane;
    v = DPPADD(v, 0xB1); v = DPPADD(v, 0x4E); v = DPPADD(v, 0x141); v = DPPADD(v, 0x140);
    const int b = __builtin_bit_cast(int, v);
    const float s0 = __builtin_bit_cast(float, __builtin_amdgcn_readlane(b, 0)), s1 = __builtin_bit_cast(float, __builtin_amdgcn_readlane(b, 16));
    const float s2 = __builtin_bit_cast(float, __builtin_amdgcn_readlane(b, 32)), s3 = __builtin_bit_cast(float, __builtin_amdgcn_readlane(b, 48));
    return (s0 + s1) + (s2 + s3);
}
__device__ __forceinline__ float silu_f(float v) { return v / (1.f + __expf(-v)); }
__device__ __forceinline__ float gelu_tanh(float v) { const float u = 0.7978845608028654f * (v + 0.044715f * v * v * v); const float e = __expf(2.f * u); return v * (1.f - 1.f / (e + 1.f)); }
__device__ __forceinline__ int lane_id() { int l; asm volatile("v_mbcnt_lo_u32_b32 %0, -1, 0\n\tv_mbcnt_hi_u32_b32 %0, -1, %0" : "=v"(l)); return l; }
__device__ __forceinline__ int crow(int r, int hi) { return (r & 3) + 8 * (r >> 2) + 4 * hi; }
__device__ __forceinline__ int mod_idx(int r) { return r < NLAT ? (r >> 13) : 4; }
__device__ __forceinline__ void tok_tile(int r, int& b, int& t, int& kk) {
    if (r < NLAT) { b = r >> 13; const int pos = r & 8191; t = pos >> 6; kk = pos & 63; }
    else { const int q = r - NLAT; b = q >> 8; const int pos = q & 255; t = 128 + (pos >> 6); kk = pos & 63; }
}
__device__ __forceinline__ int vtile_off(int kk, int d8) { return (d8 >> 2) * 4096 + (kk >> 4) * 1024 + (kk & 15) * 64 + (d8 & 3) * 16; }
__device__ __forceinline__ int ktile_off(int kk, int dc) { return dc * 1024 + kk * 16; }

namespace pg8 {
constexpr int BM = 256, BK = 64, HALF = 128, HTB = HALF * BK * 2, STAGE_BYTES = 8 * HTB, NXCD = 8, WGM = 8;
__host__ __device__ __forceinline__ int lds_byte(int r, int c) { const int st = (r >> 4) * 2 + (c >> 5), rr = r & 15, cc = c & 31, ob = rr * 64 + cc * 2; return st * 1024 + (ob ^ (((ob >> 9) & 1) << 5)); }
__host__ __device__ __forceinline__ void stage_rc(int b, int& R, int& C) { const int st = b / 1024, sb = b % 1024, swz = sb ^ (((sb >> 9) & 1) << 5); R = (st >> 1) * 16 + swz / 64; C = (st & 1) * 32 + (swz % 64) / 2; }
__host__ __device__ __forceinline__ int perm32(int rho) { const int n = rho >> 4, i = rho & 15; return 8 * (i >> 2) + 4 * n + (i & 3); }
struct Unit { int pm, pn, aux; };
struct Gemm { const bf16_t* A; const bf16_t* Bt; int lda; int K; };

struct StaticOrder {
    int nM, nN, nwg, G, c;
    __device__ void init(int M, int N, int G_, int c_) { nM = M / BM; nN = N / BM; nwg = nM * nN; G = G_; c = c_; }
    __device__ bool next(int i, Unit& u) const {
        const long L = (long)i * G + c; if (L >= nwg) return false;
        int wgid = (int)L; { const int q = nwg / NXCD, r = nwg % NXCD, xcd = wgid % NXCD, off = wgid / NXCD; wgid = (xcd < r ? xcd * (q + 1) : r * (q + 1) + (xcd - r) * q) + off; }
        const int nig = WGM * nN, gid = wgid / nig, fm = gid * WGM, gsz = (nM - fm) < WGM ? (nM - fm) : WGM;
        u.pm = fm + ((wgid % nig) % gsz); u.pn = (wgid % nig) / gsz; u.aux = 0; return true;
    }
};
struct PlainRows { static constexpr bool GATHER = false; int lda2; __device__ __forceinline__ unsigned tok(const Unit&, int) const { return 0u; } };

template <class Epi, class Sched, class ARows, bool ALIGN_EPI, bool SP2>
__device__ __forceinline__ void gemm_phase(LAS unsigned char* lds, const int tid, const Gemm g, const Sched& S, const ARows& AR, const Epi& E) {
    const int wid = __builtin_amdgcn_readfirstlane(tid >> 6), lane = tid & 63, wr = wid >> 2, wc = wid & 3, fr = lane & 15, fq = lane >> 4;
    int K = g.K; asm volatile("" : "+s"(K));
    const int nt = K / BK;
    int R0, C0; stage_rc(tid * 16, R0, C0);
    const unsigned lda2 = (unsigned)AR.lda2;
    const unsigned aLane = ARows::GATHER ? (unsigned)(C0 * 2) : (unsigned)R0 * lda2 + (unsigned)(C0 * 2);
    const unsigned voffB0 = (unsigned)(((R0 & ~31) + Epi::perm(R0 & 31)) * K + C0) * 2u;
    const size_t kstep = (size_t)(BK * 2);
    const size_t hstepB = (size_t)HALF * K * 2;
    const size_t tstepB = 2 * hstepB;
    const size_t qstepB = (size_t)64 * K * 2;
    const unsigned ldsw = (unsigned)wid * 1024u;
    const int aoff = lds_byte(wr * 64 + fr, fq * 8), boff = lds_byte(wc * 32 + fr, fq * 8);
#define PG8_SA(b, h) (((b) * 2 + (h)) * HTB)
#define PG8_SB(b, h) ((4 + (b) * 2 + (h)) * HTB)
#define PG8_STAGEB(bufoff, gbase) do { _Pragma("unroll") for (int _i = 0; _i < 2; ++_i) { \
        const char* _ub = (const char*)(gbase) + _i * qstepB; asm volatile("" : "+s"(_ub));     \
        __builtin_amdgcn_global_load_lds((const unsigned*)(_ub + voffB0), (LAS unsigned*)(lds + (bufoff) + ldsw + _i * 8192), 16, 0, 0); } } while (0)
#define PG8_STAGEA(bufoff, pm_, tk_, h, kb) do { _Pragma("unroll") for (int _i = 0; _i < 2; ++_i) { \
        const char* _ub; unsigned _vo; \
        if constexpr (ARows::GATHER) { _ub = (const char*)g.A + (kb); _vo = (((tk_)[h] >> (16 * _i)) & 0xffffu) * lda2 + aLane; } \
        else { _ub = (const char*)g.A + ((size_t)((pm_) * BM + (h) * HALF + _i * 64) * lda2 + (kb)); _vo = aLane; } \
        asm volatile("" : "+s"(_ub)); \
        __builtin_amdgcn_global_load_lds((const unsigned*)(_ub + _vo), (LAS unsigned*)(lds + (bufoff) + ldsw + _i * 8192), 16, 0, 0); } } while (0)
#define PG8_LDA(dst, b, h) do { _Pragma("unroll") for (int m = 0; m < 4; ++m) _Pragma("unroll") for (int k = 0; k < 2; ++k) dst[m][k] = *(const LAS bf16x8*)(lds + PG8_SA(b, h) + aoff + m * 2048 + k * 1024); } while (0)
#define PG8_LDB(dst, b, h) do { _Pragma("unroll") for (int n = 0; n < 2; ++n) _Pragma("unroll") for (int k = 0; k < 2; ++k) dst[n][k] = *(const LAS bf16x8*)(lds + PG8_SB(b, h) + boff + n * 2048 + k * 1024); } while (0)
#define PG8_MMA(ai, bj, At, Bt) do { __builtin_amdgcn_s_setprio(1); _Pragma("unroll") for (int m = 0; m < 4; ++m) _Pragma("unroll") for (int n = 0; n < 2; ++n) _Pragma("unroll") for (int k = 0; k < 2; ++k) \
        acc[ai][bj][m][n] = __builtin_amdgcn_mfma_f32_16x16x32_bf16(Bt[n][k], At[m][k], acc[ai][bj][m][n], 0, 0, 0); __builtin_amdgcn_s_setprio(0); } while (0)
#define PG8_WAIT_V(n) asm volatile("s_waitcnt vmcnt(" #n ")" ::: "memory")
#define PG8_WAIT_L(n) asm volatile("s_waitcnt lgkmcnt(" #n ")" ::: "memory")
#define PG8_BAR __builtin_amdgcn_s_barrier()
#define PG8_SCHED __builtin_amdgcn_sched_barrier(0)
#define PG8_TOKS(tk_, u) do { if constexpr (ARows::GATHER) { _Pragma("unroll") for (int _h = 0; _h < 2; ++_h) (tk_)[_h] = AR.tok((u), _h * HALF + R0) | (AR.tok((u), _h * HALF + 64 + R0) << 16); } } while (0)
    Unit cur, nxt; int ui = 0;
    if (!S.next(0, cur)) return;
    cur.pm = __builtin_amdgcn_readfirstlane(cur.pm); cur.pn = __builtin_amdgcn_readfirstlane(cur.pn); cur.aux = __builtin_amdgcn_readfirstlane(cur.aux);
    f32x4 acc[2][2][4][2];
#pragma unroll
    for (int a = 0; a < 2; ++a)
#pragma unroll
        for (int b = 0; b < 2; ++b)
#pragma unroll
            for (int m = 0; m < 4; ++m)
#pragma unroll
                for (int n = 0; n < 2; ++n) acc[a][b][m][n] = (f32x4){0.f, 0.f, 0.f, 0.f};
    bf16x8 At[4][2], B0[2][2], B1[2][2];
    unsigned tkC[2] = {0u, 0u}, tkN[2] = {0u, 0u};
    PG8_TOKS(tkC, cur);
    const char* cB = (const char*)g.Bt + (size_t)cur.pn * tstepB;
    static_assert(SP2, "only the SP2 loop is kept");
    PG8_STAGEB(PG8_SB(0, 0), cB); PG8_STAGEB(PG8_SB(0, 1), cB + hstepB); PG8_STAGEA(PG8_SA(0, 0), cur.pm, tkC, 0, 0); PG8_STAGEA(PG8_SA(0, 1), cur.pm, tkC, 1, 0);
    if (wr == 1) PG8_BAR;
    PG8_WAIT_V(2); PG8_BAR;
    PG8_STAGEB(PG8_SB(1, 0), cB + kstep); PG8_STAGEA(PG8_SA(1, 0), cur.pm, tkC, 0, kstep); PG8_STAGEB(PG8_SB(1, 1), cB + hstepB + kstep);
    PG8_WAIT_V(6); PG8_BAR;
    for (;;) {
        const bool has_next = S.next(ui + 1, nxt);
        if (!has_next) nxt = cur;
        nxt.pm = __builtin_amdgcn_readfirstlane(nxt.pm); nxt.pn = __builtin_amdgcn_readfirstlane(nxt.pn); nxt.aux = __builtin_amdgcn_readfirstlane(nxt.aux);
        PG8_TOKS(tkN, nxt);
        const char* nB = (const char*)g.Bt + (size_t)nxt.pn * tstepB;
        for (int t = 0; t < nt; t += 2) {
            const bool last = (t == nt - 2);
            const size_t k1 = (size_t)(t + 1) * kstep;
            const size_t k2 = last ? 0 : (size_t)(t + 2) * kstep, k3 = k2 + kstep;
            const int pm2 = last ? nxt.pm : cur.pm;
            const char* b2 = last ? nB : cB + (size_t)(t + 2) * kstep; const char* b3 = b2 + kstep;
            PG8_LDB(B0, 0, 0); PG8_LDB(B1, 0, 1); PG8_SCHED; PG8_LDA(At, 0, 0); PG8_STAGEA(PG8_SA(1, 1), cur.pm, tkC, 1, k1);
            PG8_WAIT_V(8); PG8_WAIT_L(0); PG8_BAR; PG8_MMA(0, 0, At, B0); PG8_MMA(0, 1, At, B1); PG8_BAR; PG8_SCHED;
            PG8_LDA(At, 0, 1); PG8_STAGEB(PG8_SB(0, 0), b2); PG8_STAGEB(PG8_SB(0, 1), b2 + hstepB); if (last) PG8_STAGEA(PG8_SA(0, 0), pm2, tkN, 0, k2); else PG8_STAGEA(PG8_SA(0, 0), pm2, tkC, 0, k2);
            PG8_WAIT_V(8); PG8_WAIT_L(0); PG8_BAR; PG8_MMA(1, 0, At, B0); PG8_MMA(1, 1, At, B1); PG8_BAR; PG8_SCHED;
            PG8_LDB(B0, 1, 0); PG8_LDB(B1, 1, 1); PG8_SCHED; PG8_LDA(At, 1, 0); if (last) PG8_STAGEA(PG8_SA(0, 1), pm2, tkN, 1, k2); else PG8_STAGEA(PG8_SA(0, 1), pm2, tkC, 1, k2);
            PG8_WAIT_V(8); PG8_WAIT_L(0); PG8_BAR; PG8_MMA(0, 0, At, B0); PG8_MMA(0, 1, At, B1); PG8_BAR; PG8_SCHED;
            PG8_LDA(At, 1, 1); PG8_STAGEB(PG8_SB(1, 0), b3); PG8_STAGEB(PG8_SB(1, 1), b3 + hstepB); if (last) PG8_STAGEA(PG8_SA(1, 0), pm2, tkN, 0, k3); else PG8_STAGEA(PG8_SA(1, 0), pm2, tkC, 0, k3);
            PG8_WAIT_V(8); PG8_WAIT_L(0); PG8_BAR; PG8_MMA(1, 0, At, B0); PG8_MMA(1, 1, At, B1); PG8_BAR; PG8_SCHED;
        }
        if constexpr (ALIGN_EPI) { if (wr == 0) PG8_BAR; }
        E(acc, cur, wr, wc, fr, fq);
        if (!has_next) break;
#pragma unroll
        for (int a = 0; a < 2; ++a)
#pragma unroll
            for (int b = 0; b < 2; ++b)
#pragma unroll
                for (int m = 0; m < 4; ++m)
#pragma unroll
                    for (int n = 0; n < 2; ++n) acc[a][b][m][n] = (f32x4){0.f, 0.f, 0.f, 0.f};
        cur = nxt; cB = nB; ++ui;
#pragma unroll
        for (int _h = 0; _h < 2; ++_h) tkC[_h] = tkN[_h];
        if constexpr (ALIGN_EPI) { if (wr == 1) PG8_BAR; }
    }
    PG8_WAIT_V(0);
    if constexpr (!ALIGN_EPI) { if (wr == 0) PG8_BAR; }
    PG8_BAR;
#undef PG8_SA
#undef PG8_SB
#undef PG8_STAGEA
#undef PG8_STAGEB
#undef PG8_LDA
#undef PG8_LDB
#undef PG8_MMA
#undef PG8_WAIT_V
#undef PG8_WAIT_L
#undef PG8_BAR
#undef PG8_SCHED
#undef PG8_TOKS
}
}
__device__ __forceinline__ u32x4 pack8(const f32x4 a, const f32x4 b, float s) { u32x4 w; w.x = pk2(a[0] * s, a[1] * s); w.y = pk2(a[2] * s, a[3] * s); w.z = pk2(b[0] * s, b[1] * s); w.w = pk2(b[2] * s, b[3] * s); return w; }

struct EpiZ {
    static __host__ __device__ __forceinline__ int perm(int r) { return pg8::perm32(r); }
    bf16_t* Z; unsigned char* NK; unsigned char* NV;
    __device__ __forceinline__ void operator()(const f32x4 (&acc)[2][2][4][2], const pg8::Unit& u, int wr, int wc, int fr, int fq) const {
        const int pn = u.pn;
        if (pn == 6 || pn == 7) {
            const int b = u.pm < 128 ? (u.pm >> 5) : (u.pm - 128), t0 = u.pm < 128 ? (u.pm & 31) * 4 : 128;
#pragma unroll
            for (int bj = 0; bj < 2; ++bj) { const int col = bj * 128 + wc * 32 + 8 * fq; const int h = col >> 6, d8 = (col & 63) >> 3;
                unsigned char* tb = (pn == 6 ? NK : NV) + (size_t)((b * 4 + h) * NTILE + t0 + wr) * 8192;
                const int lo = pn == 6 ? (d8 * 1024 + fr * 16) : ((d8 >> 2) * 4096 + fr * 64 + (d8 & 3) * 16);
#pragma unroll
                for (int ai = 0; ai < 2; ++ai)
#pragma unroll
                    for (int m = 0; m < 4; ++m) *(u32x4*)(tb + ai * 2 * 8192 + (pn == 6 ? m * 256 : m * 1024) + lo) = pack8(acc[ai][bj][m][0], acc[ai][bj][m][1], 1.f); }
        } else {
            const float s = pn == 5 ? NA_QSCALE : 1.f;
            #pragma unroll
            for (int ai = 0; ai < 2; ++ai)
            #pragma unroll
            for (int m = 0; m < 4; ++m) { const int rl = ai * 128 + wr * 64 + m * 16 + fr; const int row = u.pm * 256 + rl; (void)rl; (void)row;
                bf16_t* rowp = Z + (size_t)row * ZP + pn * 256 + wc * 32 + 8 * fq;
#pragma unroll
                for (int bj = 0; bj < 2; ++bj) *(u32x4*)(rowp + bj * 128) = pack8(acc[ai][bj][m][0], acc[ai][bj][m][1], s);
            }
        }
    }
};

struct EpiQ {
    static __host__ __device__ __forceinline__ int perm(int r) { return pg8::perm32(r); }
    bf16_t* QM;
    __device__ __forceinline__ void operator()(const f32x4 (&acc)[2][2][4][2], const pg8::Unit& u, int wr, int wc, int fr, int fq) const {
#pragma unroll
        for (int ai = 0; ai < 2; ++ai)
#pragma unroll
            for (int m = 0; m < 4; ++m) { const int row = u.pm * 256 + ai * 128 + wr * 64 + m * 16 + fr;
#pragma unroll
                for (int bj = 0; bj < 2; ++bj) { const int cb = u.pn * 256 + bj * 128 + wc * 32;
                    if (cb < 384) *(u32x4*)(QM + (size_t)row * 384 + cb + 8 * fq) = pack8(acc[ai][bj][m][0], acc[ai][bj][m][1], MLA_QSCALE); } }
    }
};

struct EpiKV {
    static __host__ __device__ __forceinline__ int perm(int r) { return pg8::perm32(r); }
    unsigned char* MK; unsigned char* MV;
    __device__ __forceinline__ void operator()(const f32x4 (&acc)[2][2][4][2], const pg8::Unit& u, int wr, int wc, int fr, int fq) const {
        const int b = u.pm < 128 ? (u.pm >> 5) : (u.pm - 128), t0 = u.pm < 128 ? (u.pm & 31) * 4 : 128;
#pragma unroll
        for (int bj = 0; bj < 2; ++bj) { const int col = u.pn * 256 + bj * 128 + wc * 32 + 8 * fq; const int h = col >> 7, isv = (col >> 6) & 1, d8 = (col & 63) >> 3;
            const size_t tile = (size_t)((b * 4 + h) * NTILE + t0 + wr);
            if (isv) { unsigned char* tb = MV + tile * VB + (d8 >> 2) * 4096 + fr * 64 + (d8 & 3) * 16;
#pragma unroll
                for (int ai = 0; ai < 2; ++ai)
#pragma unroll
                    for (int m = 0; m < 4; ++m) *(u32x4*)(tb + ai * 2 * VB + m * 1024) = pack8(acc[ai][bj][m][0], acc[ai][bj][m][1], 1.f);
            } else { unsigned char* tb = MK + tile * MKB + d8 * 1024 + fr * 16;
#pragma unroll
                for (int ai = 0; ai < 2; ++ai)
#pragma unroll
                    for (int m = 0; m < 4; ++m) *(u32x4*)(tb + ai * 2 * MKB + m * 256) = pack8(acc[ai][bj][m][0], acc[ai][bj][m][1], 1.f); } }
    }
};

struct EpiOut {
    static __host__ __device__ __forceinline__ int perm(int r) { return pg8::perm32(r); }
    const float* res_lat; const float* res_ctx; float* x_lat; float* x_ctx; const float* g1;
    __device__ __forceinline__ void operator()(const f32x4 (&acc)[2][2][4][2], const pg8::Unit& u, int wr, int wc, int fr, int fq) const {
        const bool latent = u.pm < 128;
        const int bb = latent ? (u.pm >> 5) : 4;
        const float* rbase = latent ? res_lat : res_ctx - (size_t)NLAT * D;
        float* xbase = latent ? x_lat : x_ctx - (size_t)NLAT * D;
        const int c0 = u.pn * 256 + wc * 32 + 8 * fq;
        f32x4 gv[2][2];
#pragma unroll
        for (int bj = 0; bj < 2; ++bj)
#pragma unroll
            for (int n = 0; n < 2; ++n) gv[bj][n] = *(const f32x4*)(g1 + bb * 6144 + c0 + bj * 128 + 4 * n);
        #pragma unroll
        for (int ai = 0; ai < 2; ++ai)
        #pragma unroll
        for (int m = 0; m < 4; ++m) { const int rl = ai * 128 + wr * 64 + m * 16 + fr; const int row = u.pm * 256 + rl; (void)rl; (void)row;
#pragma unroll
            for (int bj = 0; bj < 2; ++bj)
#pragma unroll
                for (int n = 0; n < 2; ++n) { const size_t off = (size_t)row * D + c0 + bj * 128 + 4 * n;
                    const f32x4 r = *(const f32x4*)(rbase + off); *(f32x4*)(xbase + off) = r + gv[bj][n] * acc[ai][bj][m][n]; }
        }
    }
};

struct EpiMoe1 {
    static __host__ __device__ __forceinline__ int perm(int r) { return pg8::perm32(r); }
    bf16_t* H1;
    __device__ __forceinline__ void operator()(const f32x4 (&acc)[2][2][4][2], const pg8::Unit& u, int wr, int wc, int fr, int fq) const {
        #pragma unroll
        for (int ai = 0; ai < 2; ++ai)
        #pragma unroll
        for (int m = 0; m < 4; ++m) { const int rl = ai * 128 + wr * 64 + m * 16 + fr; const int row = u.pm * 256 + rl; (void)rl; (void)row;
            f32x4 h0; f32x4 h1;
#pragma unroll
            for (int e = 0; e < 4; ++e) { h0[e] = silu_f(acc[ai][0][m][0][e]) * acc[ai][1][m][0][e]; h1[e] = silu_f(acc[ai][0][m][1][e]) * acc[ai][1][m][1][e]; }
            *(u32x4*)(H1 + (size_t)row * DE + (u.pn & 3) * 128 + wc * 32 + 8 * fq) = pack8(h0, h1, 1.f);
        }
    }
};
struct EpiMoe2 {
    static __host__ __device__ __forceinline__ int perm(int r) { return pg8::perm32(r); }
    bf16_t* Y;
    __device__ __forceinline__ void operator()(const f32x4 (&acc)[2][2][4][2], const pg8::Unit& u, int wr, int wc, int fr, int fq) const {
        #pragma unroll
        for (int ai = 0; ai < 2; ++ai)
        #pragma unroll
        for (int m = 0; m < 4; ++m) { const int rl = ai * 128 + wr * 64 + m * 16 + fr; const int row = u.pm * 256 + rl; (void)rl; (void)row;
            bf16_t* rowp = Y + (size_t)row * D + (u.pn & 3) * 256 + wc * 32 + 8 * fq;
#pragma unroll
            for (int bj = 0; bj < 2; ++bj) *(u32x4*)(rowp + bj * 128) = pack8(acc[ai][bj][m][0], acc[ai][bj][m][1], 1.f);
        }
    }
};

struct MoeOrder {
    const LAS int* tb; int G, c;
    __device__ __forceinline__ bool next(int i, pg8::Unit& u) const {
        const int L = i * G + c; const int ntl = tb[32];
        if (L >= ntl * 4) return false;
        const int rt = L >> 2; int e = 0;
        for (int j = 1; j < 32; ++j) e += (tb[j] <= rt) ? 1 : 0;
        u.pm = rt; u.pn = e * 4 + (L & 3); u.aux = e; return true;
    }
};
struct MoeRows1 {
    static constexpr bool GATHER = true;
    int lda2; const LAS int* tb; const LAS int* cn; const int* list;
    __device__ __forceinline__ unsigned tok(const pg8::Unit& u, int lr) const {
        const int e = u.aux; int j = (u.pm - tb[e]) * 256 + lr; const int c = cn[e]; j = j < c ? j : c - 1;
        return (unsigned)(*(const int*)((const char*)list + (size_t)e * MT * 4 + (size_t)(unsigned)(j * 4)) >> 1);
    }
};
__device__ __forceinline__ s16x4 vtr(const LAS unsigned char* p) { typedef short v4i16_t __attribute__((ext_vector_type(4))); return __builtin_bit_cast(s16x4, __builtin_amdgcn_ds_read_tr16_b64_v4i16((LAS v4i16_t*)p)); }

__device__ __forceinline__ void glds16(const void* gsrc, unsigned lds_dst) { unsigned keep;
    asm volatile("s_mov_b32 %0, m0\n\ts_mov_b32 m0, %2\n\ts_nop 0\n\tglobal_load_lds_dwordx4 %1, off\n\ts_mov_b32 m0, %0" : "=&s"(keep) : "v"(gsrc), "s"(lds_dst) : "memory"); }

__device__ __forceinline__ float max3f(float a, float b, float c) { float r; asm("v_max3_f32 %0, %1, %2, %3" : "=v"(r) : "v"(a), "v"(b), "v"(c)); return r; }
__device__ __forceinline__ float max2f(float a, float b) { float r; asm("v_max_f32_e32 %0, %1, %2" : "=v"(r) : "v"(a), "v"(b)); return r; }
__device__ __forceinline__ float fadd_s(float a, float b) { float r; asm("v_add_f32_e32 %0, %1, %2" : "=v"(r) : "v"(a), "v"(b)); return r; }

struct NaInfo { int active_lo, active_hi;
                int qrow, qcol, c0; const LAS float* tab; };

template <int KS, bool ISNA, bool ROPEQ>
__device__ __forceinline__ void attn_unit(LAS unsigned char* lds, const int tid, const bf16_t* Qw  , int qpitch,
                                          const unsigned char* Kt, const unsigned char* Vt, int a0, int na, int nb, bf16_t* Ow, const NaInfo& ni, const float* rope_row  ) {
    constexpr int KB = KS * 2048, TB = KB + 8192, NPK = KB / 1024, NP = NPK + 8;
    const int lane = tid & 63, r32 = lane & 31, hi = lane >> 5; const int wid = __builtin_amdgcn_readfirstlane(tid >> 6);
    const int NT = na + nb;
#define TIX(i) ((i) < na ? a0 + (i) : 128 + (i) - na)
    const unsigned lds0 = (unsigned)(__UINTPTR_TYPE__)lds;
#define ISSUE(i, slot) do { const int tx_ = TIX(i); _Pragma("unroll") for (int pp = 0; pp < 3; ++pp) { const int p_ = wid + 8 * pp; if (p_ < NP) { \
        const unsigned char* src_ = (p_ < NPK) ? (Kt + (size_t)tx_ * KB + p_ * 1024) : (Vt + (size_t)tx_ * VB + (p_ - NPK) * 1024); \
        glds16(src_ + lane * 16, (unsigned)__builtin_amdgcn_readfirstlane(lds0 + (slot) * TB + p_ * 1024)); } } } while (0)
#define WAITBAR(N) asm volatile("s_waitcnt vmcnt(" #N ") lgkmcnt(0)\n\ts_barrier" ::: "memory")
    const bool w3 = (NP > 16) && (wid < NP - 16);
    ISSUE(0, 0);
    if (NT > 1) ISSUE(1, 1);
    bf16x8 qf[KS];
#pragma unroll
    for (int s = 0; s < KS; ++s) qf[s] = *(const bf16x8*)(Qw + (size_t)r32 * qpitch + s * 16 + hi * 8);
    if constexpr (ROPEQ) {
        static_assert(KS == 6, "rope only on the MLA query");
        const float* rt = rope_row + (size_t)r32 * 32;
        const float sg = hi ? 1.f : -1.f;
#pragma unroll
        for (int s = 4; s < 6; ++s) {
            u32x4 w = __builtin_bit_cast(u32x4, qf[s]); u32x4 pw; u32x4 ow;
#pragma unroll
            for (int e = 0; e < 4; ++e) pw[e] = shxu(w[e], 32, lane);
#pragma unroll
            for (int e = 0; e < 4; ++e) { const f32x4 cs = *(const f32x4*)(rt + (s - 4) * 16 + 4 * e);
                const float lo = bf_lo(w[e]) * cs[0] + sg * bf_lo(pw[e]) * cs[1], hh = bf_hi(w[e]) * cs[2] + sg * bf_hi(pw[e]) * cs[3];
                ow[e] = pk2(lo, hh); }
            qf[s] = __builtin_bit_cast(bf16x8, ow);
        }
    }
    f32x16 o0 = {}, o1 = {};
    f32x16 negm = {};
    f32x16 p0 = {}, p1 = {};
    float mrun = 0.f, lrun = 0.f;
    bool first = true;
#define STAGE_QK(i, b) do { \
        const LAS unsigned char* kb_ = lds + (b) * TB + hi * 1024 + r32 * 16; \
        bf16x8 kf_[2 * KS]; \
        _Pragma("unroll") for (int s = 0; s < KS; ++s) { kf_[2 * s] = *(const LAS bf16x8*)(kb_ + s * 2048); kf_[2 * s + 1] = *(const LAS bf16x8*)(kb_ + s * 2048 + 512); } \
        __builtin_amdgcn_sched_barrier(0); \
        __builtin_amdgcn_s_setprio(1); \
        _Pragma("unroll") for (int s = 0; s < KS; ++s) { \
            p0 = __builtin_amdgcn_mfma_f32_32x32x16_bf16(kf_[2 * s], qf[s], s == 0 ? negm : p0, 0, 0, 0); \
            p1 = __builtin_amdgcn_mfma_f32_32x32x16_bf16(kf_[2 * s + 1], qf[s], s == 0 ? negm : p1, 0, 0, 0); } \
        __builtin_amdgcn_s_setprio(0); \
        if (ISNA && (i) < na) { const int dr_ = a0 + (i) - ni.qrow + 7; \
            int ib_ = 4 * hi - ni.qcol + 63, wb_ = 4 * hi - ni.c0; asm volatile("" : "+v"(ib_), "+v"(wb_));     \
            const LAS float* trow = ni.tab + dr_ * 128 + ib_;        \
            _Pragma("unroll") for (int r = 0; r < 16; ++r) { \
                const int c_ = (r & 3) + 8 * (r >> 2); \
                const float b0 = trow[c_], b1 = trow[c_ + 32]; \
                p0[r] = ((unsigned)(wb_ + c_) < 16u) ? p0[r] + b0 : -1e30f; \
                p1[r] = ((unsigned)(wb_ + c_ + 32) < 16u) ? p1[r] + b1 : -1e30f; } } \
    } while (0)
#define STAGE_SMPV(b) do { \
        const LAS unsigned char* vb_ = lds + (b) * TB + KB + ((lane >> 4) & 1) * 32 + (lane & 3) * 8 + (4 * hi + ((lane & 15) >> 2)) * 64; \
        s16x4 vl0[4], vh0[4], vl1[4], vh1[4]; \
        _Pragma("unroll") for (int ks = 0; ks < 4; ++ks) { vl0[ks] = vtr(vb_ + ks * 1024); vh0[ks] = vtr(vb_ + ks * 1024 + 512); vl1[ks] = vtr(vb_ + 4096 + ks * 1024); vh1[ks] = vtr(vb_ + 4096 + ks * 1024 + 512); } \
        __builtin_amdgcn_sched_barrier(0); \
        asm volatile("s_nop 15\n\ts_nop 7" : "+v"(p0), "+v"(p1));     \
        float mxa = max3f(p0[0], p0[1], p1[0]), mxb = max3f(p0[2], p0[3], p1[1]); mxa = max3f(mxa, p1[2], p1[3]); \
        _Pragma("unroll") for (int r = 4; r < 16; r += 4) { mxa = max3f(mxa, p0[r], p0[r + 1]); mxb = max3f(mxb, p0[r + 2], p0[r + 3]); mxa = max3f(mxa, p1[r], p1[r + 1]); mxb = max3f(mxb, p1[r + 2], p1[r + 3]); } \
        float mx = max2f(mxa, mxb); \
        mx = max2f(mx, shx(mx, 32, lane)); \
          \
        if (first || __any(mx > 8.0f)) { \
            const float dl = first ? mx : fmaxf(mx, 0.f); \
            const float alpha = __builtin_amdgcn_exp2f(-dl);       \
            mrun += dl; lrun *= alpha; \
            _Pragma("unroll") for (int r = 0; r < 16; ++r) { p0[r] -= dl; p1[r] -= dl; o0[r] *= alpha; o1[r] *= alpha; negm[r] = -mrun; } \
            first = false; } \
        float psa = 0.f, psb = 0.f; \
        _Pragma("unroll") for (int r = 0; r < 16; ++r) { p0[r] = __builtin_amdgcn_exp2f(p0[r]); p1[r] = __builtin_amdgcn_exp2f(p1[r]); psa += p0[r]; psb += p1[r]; } \
        lrun += psa + psb; \
        bf16x8 pf[4]; \
        { u32x4 w; \
          w.x = pk2(p0[0], p0[1]); w.y = pk2(p0[2], p0[3]); w.z = pk2(p0[4], p0[5]); w.w = pk2(p0[6], p0[7]); pf[0] = __builtin_bit_cast(bf16x8, w); \
          w.x = pk2(p0[8], p0[9]); w.y = pk2(p0[10], p0[11]); w.z = pk2(p0[12], p0[13]); w.w = pk2(p0[14], p0[15]); pf[1] = __builtin_bit_cast(bf16x8, w); \
          w.x = pk2(p1[0], p1[1]); w.y = pk2(p1[2], p1[3]); w.z = pk2(p1[4], p1[5]); w.w = pk2(p1[6], p1[7]); pf[2] = __builtin_bit_cast(bf16x8, w); \
          w.x = pk2(p1[8], p1[9]); w.y = pk2(p1[10], p1[11]); w.z = pk2(p1[12], p1[13]); w.w = pk2(p1[14], p1[15]); pf[3] = __builtin_bit_cast(bf16x8, w); } \
        _Pragma("unroll") for (int ks = 0; ks < 4; ++ks) { \
            const bf16x8 va0 = {vl0[ks][0], vl0[ks][1], vl0[ks][2], vl0[ks][3], vh0[ks][0], vh0[ks][1], vh0[ks][2], vh0[ks][3]}; \
            const bf16x8 va1 = {vl1[ks][0], vl1[ks][1], vl1[ks][2], vl1[ks][3], vh1[ks][0], vh1[ks][1], vh1[ks][2], vh1[ks][3]}; \
            o0 = __builtin_amdgcn_mfma_f32_32x32x16_bf16(va0, pf[ks], o0, 0, 0, 0); \
            o1 = __builtin_amdgcn_mfma_f32_32x32x16_bf16(va1, pf[ks], o1, 0, 0, 0); } \
    } while (0)
    for (int i = 0; i < NT; ++i) {
        if (i + 1 < NT) { if (w3) WAITBAR(3); else WAITBAR(2); } else WAITBAR(0);
        if (i + 2 < NT) ISSUE(i + 2, (i + 2) & 3);
        bool active = true;
        if (ISNA && i < na) { const int krow = a0 + i; active = (krow >= ni.active_lo) && (krow <= ni.active_hi); }
        if (active) { STAGE_QK(i, (i & 3)); STAGE_SMPV((i & 3)); }
    }
    asm volatile("s_waitcnt lgkmcnt(0)\n\ts_barrier" ::: "memory");
    const float ltot = lrun + shx(lrun, 32, lane);
    const float inv = 1.0f / ltot;
    bf16_t* orow = Ow + (size_t)r32 * D;
#pragma unroll
    for (int g = 0; g < 4; ++g) {
        u32x2 w0, w1;
        w0.x = pk2(o0[4 * g] * inv, o0[4 * g + 1] * inv); w0.y = pk2(o0[4 * g + 2] * inv, o0[4 * g + 3] * inv);
        w1.x = pk2(o1[4 * g] * inv, o1[4 * g + 1] * inv); w1.y = pk2(o1[4 * g + 2] * inv, o1[4 * g + 3] * inv);
        *(u32x2*)(orow + 8 * g + 4 * hi) = w0;
        *(u32x2*)(orow + 32 + 8 * g + 4 * hi) = w1;
    }
#undef TIX
#undef ISSUE
#undef WAITBAR
#undef STAGE_QK
#undef STAGE_SMPV
}
#define XB_TMO      128
#define XB_XCNT(j)  (256  + 64 * (j))
#define XB_XSUB(j)  (1280 + 64 * (j))
#define XB_XGEN(j)  (2304 + 64 * (j))
#define XB_TOP      3328
#define XB_TOPGEN   3392
#define XCD_BAR_WORDS 3456
#define XB_SPIN_CAP (1u << 18)
__device__ __forceinline__ unsigned xb_ld(unsigned* p)              { return __hip_atomic_load(p, __ATOMIC_RELAXED, __HIP_MEMORY_SCOPE_AGENT); }
__device__ __forceinline__ unsigned xb_add(unsigned* p, unsigned v) { return __hip_atomic_fetch_add(p, v, __ATOMIC_RELAXED, __HIP_MEMORY_SCOPE_AGENT); }
__device__ __forceinline__ unsigned xb_xcc_id() { return (unsigned)__builtin_amdgcn_s_getreg((3 << 11) | 20) & 0xFu; }
#define XB_SPIN(cond, bar) do { unsigned _sp = 0; while (cond) { __builtin_amdgcn_s_sleep(1); \
    if ((++_sp & 255u) == 0u) { if (xb_ld(&(bar)[XB_TMO])) break; if (_sp > XB_SPIN_CAP) { atomicAdd(&(bar)[XB_TMO], 1u); break; } } } } while (0)
struct XcdBarrier { unsigned* bar; unsigned x; volatile LAS unsigned* st; };
__device__ __forceinline__ XcdBarrier xcd_barrier_post(unsigned* bar, volatile LAS unsigned* st, int tid) {
    XcdBarrier b; b.bar = bar; b.x = xb_xcc_id(); b.st = st;
    if (tid == 0) (void)xb_add(&bar[XB_XCNT(b.x)], 1u);
    return b;
}
__device__ __forceinline__ void xcd_barrier_complete(unsigned* bar, unsigned x, unsigned& nloc, unsigned& nx) {
    const unsigned G = gridDim.x * gridDim.y * gridDim.z;
    unsigned sum, cnt, mine, sp = 0u;
    for (;;) {
        sum = 0u; cnt = 0u; mine = 0u;
#pragma unroll
        for (unsigned j = 0; j < 16; ++j) { const unsigned c = xb_ld(&bar[XB_XCNT(j)]); sum += c; cnt += (c > 0u) ? 1u : 0u; mine = (j == x) ? c : mine; }
        if (sum == G) break;
        __builtin_amdgcn_s_sleep(1);
        if ((++sp & 255u) == 0u) { if (xb_ld(&bar[XB_TMO])) break; if (sp > XB_SPIN_CAP) { atomicAdd(&bar[XB_TMO], 1u); break; } }
    }
    nloc = mine > 0u ? mine : 1u; nx = cnt > 0u ? cnt : 1u;
}
__device__ __forceinline__ void xcd_barrier(const XcdBarrier& b, int tid) {
    asm volatile("s_waitcnt vmcnt(0)" ::: "memory");
    __syncthreads();
    if (tid == 0) {
        unsigned* bar = b.bar;
        __builtin_amdgcn_s_waitcnt(0);
        unsigned nloc = b.st[0], nx = b.st[1];
        if (nloc == 0u) { xcd_barrier_complete(bar, b.x, nloc, nx); b.st[0] = nloc; b.st[1] = nx; }
        const unsigned old = xb_add(&bar[XB_XSUB(b.x)], 1u);
        const unsigned gen = old / nloc;
        if (old + 1u == (gen + 1u) * nloc) {
            __builtin_amdgcn_fence(__ATOMIC_RELEASE, "agent");
            asm volatile("s_waitcnt vmcnt(0)" ::: "memory");
            const unsigned og = xb_add(&bar[XB_TOP], 1u);
            const unsigned tg = og / nx;
            if (og + 1u == (tg + 1u) * nx) xb_add(&bar[XB_TOPGEN], 1u);
            else XB_SPIN(xb_ld(&bar[XB_TOPGEN]) == tg, bar);
            __builtin_amdgcn_fence(__ATOMIC_ACQUIRE, "agent");
            xb_add(&bar[XB_XGEN(b.x)], 1u);
            asm volatile("s_waitcnt vmcnt(0)" ::: "memory");
        } else {
            XB_SPIN(xb_ld(&bar[XB_XGEN(b.x)]) == gen, bar);
            __builtin_amdgcn_fence(__ATOMIC_ACQUIRE, "agent");
            asm volatile("s_waitcnt vmcnt(0)" ::: "memory");
        }
    }
    __syncthreads();
}

struct Args { const float* in[27]; float* out; unsigned char* ws; int l_lo, l_hi, ph_lo, ph_hi, flags, pad; };
enum { I_X = 0, I_C, I_CTX, I_CCTX, I_WADA, I_BADA, I_N1G, I_N2G, I_WIN, I_CONVW, I_SGW, I_SGB, I_RPB, I_QNG, I_WUQ, I_KVNG, I_WUKV, I_ONG, I_WOUT, I_WGRP, I_BGRP, I_WEXP, I_BEXP, I_WGATE, I_WUP, I_WDOWN, I_FNG };

struct Frame {
    LAS unsigned char* lds; unsigned char* ws; float* out;
    int tid, lane, wave, G, vcu, gw, NGW, bx, wave0;
};

__device__ __forceinline__ void transpose_item(const float* W, int ldw, int K, bf16_t* WT, int k0, int n0, int drow, LAS float* scr, int lane) {
#pragma unroll 8
    for (int i = 0; i < 32; ++i) { const int kk = 2 * i + (lane >> 5); scr[kk * 33 + (lane & 31)] = W[(size_t)(k0 + kk) * ldw + n0 + (lane & 31)]; }
    asm volatile("s_waitcnt lgkmcnt(0)" ::: "memory");
    const int c = lane & 7;
#pragma unroll
    for (int j = 0; j < 4; ++j) { const int n = (lane >> 3) + 8 * j; const LAS float* s = scr + (8 * c) * 33 + n;
        u32x4 o; o.x = pk2(s[0 * 33], s[1 * 33]); o.y = pk2(s[2 * 33], s[3 * 33]); o.z = pk2(s[4 * 33], s[5 * 33]); o.w = pk2(s[6 * 33], s[7 * 33]);
        *(u32x4*)(WT + (size_t)(drow + n) * K + k0 + 8 * c) = o; }
    asm volatile("s_waitcnt lgkmcnt(0)" ::: "memory");
}

__device__ __forceinline__ void phase_prologue(Frame& F, const Args& A) {
    LAS float* scr = (LAS float*)(F.lds + F.wave * 8448);
    unsigned char* ws = F.ws;
    constexpr int IT_IN = 16 * 77, IT_OUT = 16 * 32, IT_UQ = 4 * 12, IT_UKV = 2 * 16, IT_G = 16 * 16, IT_D = 8 * 32;
    constexpr int IT_LAYER = IT_IN + IT_OUT + IT_UQ + IT_UKV + NE * (2 * IT_G + IT_D);
    for (int it = F.gw; it < NL * IT_LAYER; it += F.NGW) {
        const int l = it / IT_LAYER; int r = it % IT_LAYER;
        if (r < IT_IN) { const int kb = r / 77, nb = r % 77; transpose_item(A.in[I_WIN] + (size_t)l * D * ZC, ZC, D, (bf16_t*)(ws + WS_WIN) + (size_t)l * ZP * D, 64 * kb, 32 * nb, 32 * nb, scr, F.lane); continue; } r -= IT_IN;
        if (r < IT_OUT) { const int kb = r / 32, nb = r % 32; transpose_item(A.in[I_WOUT] + (size_t)l * D * D, D, D, (bf16_t*)(ws + WS_WOUT) + (size_t)l * D * D, 64 * kb, 32 * nb, 32 * nb, scr, F.lane); continue; } r -= IT_OUT;
        if (r < IT_UQ) { const int kb = r / 12, nb = r % 12; transpose_item(A.in[I_WUQ] + (size_t)l * 256 * 384, 384, 256, (bf16_t*)(ws + WS_WUQ) + (size_t)l * 512 * 256, 64 * kb, 32 * nb, 32 * nb, scr, F.lane); continue; } r -= IT_UQ;
        if (r < IT_UKV) { const int kb = r / 16, nb = r % 16; transpose_item(A.in[I_WUKV] + (size_t)l * 128 * 512, 512, 128, (bf16_t*)(ws + WS_WUKV) + (size_t)l * 512 * 128, 64 * kb, 32 * nb, 32 * nb, scr, F.lane); continue; } r -= IT_UKV;
        const int e = r / (2 * IT_G + IT_D); r %= (2 * IT_G + IT_D);
        const size_t le = (size_t)l * NE + e;
        if (r < 2 * IT_G) { const int up = r >= IT_G; if (up) r -= IT_G; const int kb = r / 16, nb = r % 16; const int n0 = 32 * nb;
            transpose_item(A.in[up ? I_WUP : I_WGATE] + le * D * DE, DE, D, (bf16_t*)(ws + WS_W1) + le * 1024 * 1024, 64 * kb, n0, (n0 >> 7) * 256 + (n0 & 127) + (up ? 128 : 0), scr, F.lane); continue; }
        r -= 2 * IT_G;
        { const int kb = r / 32, nb = r % 32; transpose_item(A.in[I_WDOWN] + le * DE * D, D, DE, (bf16_t*)(ws + WS_W2) + le * 1024 * 512, 64 * kb, 32 * nb, 32 * nb, scr, F.lane); }
    }
    { const int gt = F.gw * 64 + F.lane, NGT = F.NGW * 64;
      constexpr int ZW = 96 * 1024 * 2 / 16, ZQ = 128 * 256 * 2 / 16;
      for (int i = gt; i < NL * (ZW + ZQ); i += NGT) { const int l = i / (ZW + ZQ), r = i % (ZW + ZQ);
          u32x4* p = r < ZW ? (u32x4*)(ws + WS_WIN + ((size_t)l * ZP + ZC) * D * 2) + r : (u32x4*)(ws + WS_WUQ + ((size_t)l * 512 + 384) * 256 * 2) + (r - ZW);
          *p = (u32x4){0u, 0u, 0u, 0u}; }
      for (int i = gt; i < NL * 4 * 128 * 16; i += NGT) { const int ch = i & 15, row = i >> 4; const int s = ch >> 1, hi = ch & 1;
          const float* src = A.in[I_SGW] + (size_t)row * 128 + 16 * s + 4 * hi;
          u32x4 o; o.x = pk2(src[0], src[1]); o.y = pk2(src[2], src[3]); o.z = pk2(src[8], src[9]); o.w = pk2(src[10], src[11]);
          *((u32x4*)(ws + WS_SGW) + i) = o; }
      for (int i = gt; i < SEQ * 16; i += NGT) { const int t = i >> 4, p = i & 15;
          const float pos = (p < 8) ? (float)(t >> 6) : (float)(t & 63);
          const float ang = pos * powf(10000.f, -(float)(p & 7) / 8.f);
          ((f32x2*)(ws + WS_ROPE))[i] = (f32x2){cosf(ang), sinf(ang)}; }
      for (int i = gt; i < NL * 36 * 1024; i += NGT) { const int k = i & 1023, j = (i >> 10) % 36, l = i / (36 * 1024);
          ((float*)(ws + WS_RW))[i] = j < 4 ? A.in[I_WGRP][((size_t)l * D + k) * 4 + j] : A.in[I_WEXP][((size_t)l * D + k) * 32 + (j - 4)]; }
    }
    __syncthreads();
    { LAS float* red = (LAS float*)(F.lds + 8 * 8448);
      for (int it = F.vcu; it < NL * 96; it += F.G) { const int l = it / 96, col = (it % 96) * 64 + F.lane;
          const float* w = A.in[I_WADA] + (size_t)l * D * 6144 + col;
          float a0 = 0.f, a1 = 0.f, a2 = 0.f, a3 = 0.f, a4 = 0.f;
          const int kb = F.wave * 128;
#pragma unroll 16
          for (int k = 0; k < 128; ++k) { const float wv = w[(size_t)(kb + k) * 6144];
              a0 += silu_f(A.in[I_C][kb + k]) * wv; a1 += silu_f(A.in[I_C][D + kb + k]) * wv; a2 += silu_f(A.in[I_C][2 * D + kb + k]) * wv; a3 += silu_f(A.in[I_C][3 * D + kb + k]) * wv; a4 += silu_f(A.in[I_CCTX][kb + k]) * wv; }
          red[(F.wave * 5 + 0) * 64 + F.lane] = a0; red[(F.wave * 5 + 1) * 64 + F.lane] = a1; red[(F.wave * 5 + 2) * 64 + F.lane] = a2; red[(F.wave * 5 + 3) * 64 + F.lane] = a3; red[(F.wave * 5 + 4) * 64 + F.lane] = a4;
          __syncthreads();
          if (F.tid < 320) { const int bb = F.tid >> 6, ln = F.tid & 63; float s = 0.f;
#pragma unroll
              for (int wv = 0; wv < 8; ++wv) s += red[(wv * 5 + bb) * 64 + ln];
              const int cc = (it % 96) * 64 + ln;
              ((float*)(ws + WS_MOD))[((size_t)l * 5 + bb) * 6144 + cc] = s + A.in[I_BADA][l * 6144 + cc]; }
          __syncthreads(); }
    }
}

__device__ __forceinline__ void moe_tables(Frame& F, const Args& A, int l) {
    LAS int* tb = (LAS int*)(F.lds + LDS_MOE); LAS int* cn = tb + 64;
    __syncthreads();
    if (F.tid == 0) { const int* cnt = (const int*)(F.ws + WS_CTL) + CW_CNT + l * NE * 64; int acc = 0;
        for (int e = 0; e < NE; ++e) { const int c = __hip_atomic_load(cnt + e * 64, __ATOMIC_RELAXED, __HIP_MEMORY_SCOPE_AGENT); tb[e] = acc; cn[e] = c; acc += (c + 255) >> 8; }
        tb[32] = acc; }
    __syncthreads();
}

template <int U>
__device__ __forceinline__ void load_x_rows(Frame& F, const Args& A, int r0, bool from_input, int lp, f32x4 (&x)[U][4], bool write_back) {
#pragma unroll
    for (int u = 0; u < U; ++u) { const int r = r0 + u;
        const float* xr;
        if (from_input) xr = r < NLAT ? A.in[I_X] + (size_t)r * D : A.in[I_CTX] + (size_t)(r - NLAT) * D;
        else xr = r < NLAT ? F.out + (size_t)r * D : (const float*)(F.ws + WS_XC) + (size_t)(r - NLAT) * D;
#pragma unroll
        for (int i = 0; i < 4; ++i) x[u][i] = *(const f32x4*)(xr + 4 * F.lane + 256 * i); }
    if (lp >= 0) {
        const LAS int* tb = (const LAS int*)(F.lds + LDS_MOE);
        const int* asg = (const int*)(F.ws + WS_ASG); const float* gate = (const float*)(F.ws + WS_GATE);
        typedef int i32x4 __attribute__((ext_vector_type(4)));
        i32x4 as[U]; f32x2 gt[U];
#pragma unroll
        for (int u = 0; u < U; ++u) { as[u] = *(const i32x4*)(asg + 4 * (r0 + u)); gt[u] = *(const f32x2*)(gate + 2 * (r0 + u)); }
        u32x2 ya[U][4], yb[U][4];
#pragma unroll
        for (int u = 0; u < U; ++u) {
            const bf16_t* y0 = (const bf16_t*)(F.ws + WS_Y) + (size_t)(tb[as[u][0]] * 256 + as[u][1]) * D; const bf16_t* y1 = (const bf16_t*)(F.ws + WS_Y) + (size_t)(tb[as[u][2]] * 256 + as[u][3]) * D;
#pragma unroll
            for (int i = 0; i < 4; ++i) { ya[u][i] = *(const u32x2*)(y0 + 4 * F.lane + 256 * i); yb[u][i] = *(const u32x2*)(y1 + 4 * F.lane + 256 * i); } }
        const float* g2 = (const float*)(F.ws + WS_MOD) + ((size_t)lp * 5 + mod_idx(r0)) * 6144 + 5120;
#pragma unroll
        for (int i = 0; i < 4; ++i) { const int c = 4 * F.lane + 256 * i; const f32x4 gg = *(const f32x4*)(g2 + c);
#pragma unroll
            for (int u = 0; u < U; ++u) { const int r = r0 + u; const float g0 = gt[u][0], g1 = gt[u][1]; const u32x2 a = ya[u][i], b = yb[u][i];
                x[u][i][0] += gg[0] * (g0 * bf_lo(a.x) + g1 * bf_lo(b.x)); x[u][i][1] += gg[1] * (g0 * bf_hi(a.x) + g1 * bf_hi(b.x));
                x[u][i][2] += gg[2] * (g0 * bf_lo(a.y) + g1 * bf_lo(b.y)); x[u][i][3] += gg[3] * (g0 * bf_hi(a.y) + g1 * bf_hi(b.y));
                if (write_back) { float* xw = r < NLAT ? F.out + (size_t)r * D : (float*)(F.ws + WS_XC) + (size_t)(r - NLAT) * D; *(f32x4*)(xw + c) = x[u][i]; } } }
    }
}
__device__ __forceinline__ float row_rs(const f32x4 (&x)[4], int lane) {
    float ss = 0.f;
#pragma unroll
    for (int i = 0; i < 4; ++i) ss += (x[i][0] * x[i][0] + x[i][1] * x[i][1]) + (x[i][2] * x[i][2] + x[i][3] * x[i][3]);
    return 1.0f / sqrtf(wave_sum(ss, lane) * (1.f / D) + EPS);
}

template <bool DRY>
__device__ __forceinline__ void phase_norm1(Frame& F, const Args& A, int l) {
    if (l > 0) moe_tables(F, A, l - 1);
    const float* g = A.in[I_N1G] + l * D;
    constexpr int U = 2;
    for (int r0 = F.gw * U; r0 < MT; r0 += F.NGW * U) {
        f32x4 x[U][4]; load_x_rows<U>(F, A, r0, l == 0, l - 1, x, !DRY);
        float rs[U];
#pragma unroll
        for (int u = 0; u < U; ++u) rs[u] = row_rs(x[u], F.lane);
        const float* m = (const float*)(F.ws + WS_MOD) + ((size_t)l * 5 + mod_idx(r0)) * 6144;
#pragma unroll
        for (int i = 0; i < 4; ++i) { const int c = 4 * F.lane + 256 * i; const f32x4 gv = *(const f32x4*)(g + c), sc = *(const f32x4*)(m + 1024 + c), sh = *(const f32x4*)(m + c);
#pragma unroll
            for (int u = 0; u < U; ++u) { const f32x4 o = x[u][i] * rs[u] * gv * (sc + 1.f) + sh; u32x2 w; w.x = pk2(o[0], o[1]); w.y = pk2(o[2], o[3]); *(u32x2*)((bf16_t*)(F.ws + WS_HB) + (size_t)(r0 + u) * D + c) = w; } }
    }
}
__device__ __forceinline__ void phase_final(Frame& F, const Args& A) {
    moe_tables(F, A, NL - 1);
    const float* g = A.in[I_FNG];
    constexpr int U = 2;
    for (int r0 = F.gw * U; r0 < NLAT; r0 += F.NGW * U) {
        f32x4 x[U][4]; load_x_rows<U>(F, A, r0, false, NL - 1, x, false);
        float rs[U];
#pragma unroll
        for (int u = 0; u < U; ++u) rs[u] = row_rs(x[u], F.lane);
#pragma unroll
        for (int i = 0; i < 4; ++i) { const int c = 4 * F.lane + 256 * i; const f32x4 gv = *(const f32x4*)(g + c);
#pragma unroll
            for (int u = 0; u < U; ++u) *(f32x4*)(F.out + (size_t)(r0 + u) * D + c) = x[u][i] * rs[u] * gv; }
    }
}

__device__ __forceinline__ void phase_conv(Frame& F, const Args& A, int l) {
    const bf16_t* Z = (const bf16_t*)(F.ws + WS_Z); bf16_t* YC = (bf16_t*)(F.ws + WS_YC);
    const float* cw = A.in[I_CONVW] + l * 768;
    const int nrow = (l < NL - 1) ? MT : NLAT; int extra = nrow / 128 - F.G; extra = (extra > 0 && extra < F.G) ? extra : 0;
    if (F.vcu < extra) return;
    for (int it = (F.vcu - extra) * 512 + F.tid; it < nrow * 32; it += (F.G - extra) * 512) {
        const int r = it >> 5, cg = (it & 31) * 8;
        int t, n; if (r < NLAT) { t = r & 8191; n = SEQ; } else { t = (r - NLAT) & 255; n = CTX; }
        float acc[8] = {0.f, 0.f, 0.f, 0.f, 0.f, 0.f, 0.f, 0.f};
#pragma unroll
        for (int k = 0; k < 3; ++k) { const int tt = t + k - 1;
            if (tt >= 0 && tt < n) { const bf16_t* z = Z + (size_t)(r + k - 1) * ZP; const u32x4 c = *(const u32x4*)(z + 256 + cg), hx = *(const u32x4*)(z + 512 + cg);
                const f32x4 w0 = *(const f32x4*)(cw + k * 256 + cg), w1 = *(const f32x4*)(cw + k * 256 + cg + 4);
                acc[0] += bf_lo(c.x) * bf_lo(hx.x) * w0[0]; acc[1] += bf_hi(c.x) * bf_hi(hx.x) * w0[1]; acc[2] += bf_lo(c.y) * bf_lo(hx.y) * w0[2]; acc[3] += bf_hi(c.y) * bf_hi(hx.y) * w0[3];
                acc[4] += bf_lo(c.z) * bf_lo(hx.z) * w1[0]; acc[5] += bf_hi(c.z) * bf_hi(hx.z) * w1[1]; acc[6] += bf_lo(c.w) * bf_lo(hx.w) * w1[2]; acc[7] += bf_hi(c.w) * bf_hi(hx.w) * w1[3]; } }
        const u32x4 bg = *(const u32x4*)(Z + (size_t)r * ZP + cg);
        u32x4 o; o.x = pk2(bf_lo(bg.x) * acc[0], bf_hi(bg.x) * acc[1]); o.y = pk2(bf_lo(bg.y) * acc[2], bf_hi(bg.y) * acc[3]); o.z = pk2(bf_lo(bg.z) * acc[4], bf_hi(bg.z) * acc[5]); o.w = pk2(bf_lo(bg.w) * acc[6], bf_hi(bg.w) * acc[7]);
        *(u32x4*)(YC + (size_t)r * D + cg) = o;
    }
}

__device__ __forceinline__ void phase_sg(Frame& F, const Args& A, int l) {
    const bf16_t* Z = (const bf16_t*)(F.ws + WS_Z); bf16_t* YC = (bf16_t*)(F.ws + WS_YC);
    LAS unsigned char* vt = F.lds;
    LAS float* red = (LAS float*)(F.lds + 65536);
    const int lane = F.lane, r32 = lane & 31, hi = lane >> 5, w = F.wave, h = w >> 1, pb = w & 1;
    for (int ch = F.vcu; ch < ((l < NL - 1) ? MT : NLAT) / 128; ch += F.G) {
        const int r0 = ch * 128;
        { const int tok = F.tid & 127, hq = F.tid >> 7;
          const bf16_t* zv = Z + (size_t)(r0 + tok) * ZP + 1024 + hq * 64;
          float f[64]; float s1 = 0.f;
#pragma unroll
          for (int c8 = 0; c8 < 8; ++c8) { const u32x4 v = *(const u32x4*)(zv + 8 * c8);
              f[8 * c8 + 0] = gelu_tanh(bf_lo(v.x)); f[8 * c8 + 1] = gelu_tanh(bf_hi(v.x)); f[8 * c8 + 2] = gelu_tanh(bf_lo(v.y)); f[8 * c8 + 3] = gelu_tanh(bf_hi(v.y));
              f[8 * c8 + 4] = gelu_tanh(bf_lo(v.z)); f[8 * c8 + 5] = gelu_tanh(bf_hi(v.z)); f[8 * c8 + 6] = gelu_tanh(bf_lo(v.w)); f[8 * c8 + 7] = gelu_tanh(bf_hi(v.w)); }
#pragma unroll
          for (int j = 0; j < 64; ++j) s1 += f[j];
          red[hq * 128 + tok] = s1;
          __syncthreads();
          const float mean = (red[tok] + red[128 + tok] + red[256 + tok] + red[384 + tok]) * (1.f / 256.f);
          float s2 = 0.f;
#pragma unroll
          for (int j = 0; j < 64; ++j) { f[j] -= mean; s2 += f[j] * f[j]; }
          __syncthreads();
          red[hq * 128 + tok] = s2;
          __syncthreads();
          const float rstd = 1.0f / sqrtf((red[tok] + red[128 + tok] + red[256 + tok] + red[384 + tok]) * (1.f / 256.f) + EPS);
          LAS unsigned char* tile = vt + (hq * 2 + (tok >> 6)) * 8192;
#pragma unroll
          for (int d8 = 0; d8 < 8; ++d8) { u32x4 o; o.x = pk2(f[8 * d8] * rstd, f[8 * d8 + 1] * rstd); o.y = pk2(f[8 * d8 + 2] * rstd, f[8 * d8 + 3] * rstd); o.z = pk2(f[8 * d8 + 4] * rstd, f[8 * d8 + 5] * rstd); o.w = pk2(f[8 * d8 + 6] * rstd, f[8 * d8 + 7] * rstd);
              *(LAS u32x4*)(tile + vtile_off(tok & 63, d8)) = o; }
        }
        bf16x8 bfr[2][8];
#pragma unroll
        for (int pn = 0; pn < 2; ++pn)
#pragma unroll
            for (int s = 0; s < 8; ++s) bfr[pn][s] = *(const bf16x8*)(F.ws + WS_SGW + ((((size_t)(l * 4 + h) * 128 + 64 * pb + 32 * pn + r32) * 8 + s) * 2 + hi) * 16);
        __syncthreads();
        f32x16 acc[2][2] = {};
        const LAS unsigned char* vb = vt + h * 16384 + ((lane >> 4) & 1) * 32 + (lane & 3) * 8 + (4 * hi + ((lane & 15) >> 2)) * 64;
#pragma unroll
        for (int s = 0; s < 8; ++s) {
            const LAS unsigned char* p = vb + (s >> 2) * 8192 + (s & 3) * 1024;
            const s16x4 a0l = vtr(p), a0h = vtr(p + 512), a1l = vtr(p + 4096), a1h = vtr(p + 4096 + 512);
            const bf16x8 va0 = {a0l[0], a0l[1], a0l[2], a0l[3], a0h[0], a0h[1], a0h[2], a0h[3]};
            const bf16x8 va1 = {a1l[0], a1l[1], a1l[2], a1l[3], a1h[0], a1h[1], a1h[2], a1h[3]};
#pragma unroll
            for (int pn = 0; pn < 2; ++pn) { acc[0][pn] = __builtin_amdgcn_mfma_f32_32x32x16_bf16(va0, bfr[pn][s], acc[0][pn], 0, 0, 0); acc[1][pn] = __builtin_amdgcn_mfma_f32_32x32x16_bf16(va1, bfr[pn][s], acc[1][pn], 0, 0, 0); }
        }
#pragma unroll
        for (int pn = 0; pn < 2; ++pn) { const int p = 64 * pb + 32 * pn + r32; const int row = r0 + p;
            const float bias = A.in[I_SGB][(l * 4 + h) * 128 + p];
#pragma unroll
            for (int db = 0; db < 2; ++db)
#pragma unroll
                for (int g = 0; g < 4; ++g) { const int d = 32 * db + 8 * g + 4 * hi;
                    const u32x2 uz = *(const u32x2*)(Z + (size_t)row * ZP + 768 + h * 64 + d);
                    const float u0 = gelu_tanh(bf_lo(uz.x)), u1 = gelu_tanh(bf_hi(uz.x)), u2 = gelu_tanh(bf_lo(uz.y)), u3 = gelu_tanh(bf_hi(uz.y));
                    u32x2 o; o.x = pk2(u0 * (acc[db][pn][4 * g] + bias), u1 * (acc[db][pn][4 * g + 1] + bias)); o.y = pk2(u2 * (acc[db][pn][4 * g + 2] + bias), u3 * (acc[db][pn][4 * g + 3] + bias));
                    *(u32x2*)(YC + (size_t)row * D + 256 + h * 64 + d) = o; } }
        __syncthreads();
    }
}

__device__ __forceinline__ void phase_mlaprep(Frame& F, const Args& A, int l) {
    const bf16_t* Z = (const bf16_t*)(F.ws + WS_Z);
    const float* qg = A.in[I_QNG] + l * 256; const float* kg = A.in[I_KVNG] + l * 128;
    const int lane = F.lane, j = lane & 31;
    constexpr int U = 4;
    const f32x4 gq = *(const f32x4*)(qg + 4 * lane); const float kg0 = kg[2 * lane], kg1 = kg[2 * lane + 1];
    for (int r0 = F.gw * U; r0 < MT; r0 += F.NGW * U) {
        u32x2 a[U]; unsigned kvw[U]; bf16_t kr[U]; f32x2 cs[U];
#pragma unroll
        for (int u = 0; u < U; ++u) { const bf16_t* z = Z + (size_t)(r0 + u) * ZP + 2048; a[u] = *(const u32x2*)(z + 4 * lane); kvw[u] = *(const unsigned*)(z + 256 + 2 * lane); kr[u] = z[384 + j];
            cs[u] = (f32x2){1.f, 0.f};
            if (r0 < NLAT) { const int p = (j & 7) + ((j >> 4) << 3); cs[u] = ((const f32x2*)(F.ws + WS_ROPE))[(size_t)((r0 + u) & 8191) * 16 + p]; } }
#pragma unroll
        for (int u = 0; u < U; ++u) { const int r = r0 + u;
            const float q0 = bf_lo(a[u].x), q1 = bf_hi(a[u].x), q2 = bf_lo(a[u].y), q3 = bf_hi(a[u].y);
            const float rsq = 1.0f / sqrtf(wave_sum((q0 * q0 + q1 * q1) + (q2 * q2 + q3 * q3), lane) * (1.f / 256.f) + EPS);
            u32x2 oq; oq.x = pk2(q0 * rsq * gq[0], q1 * rsq * gq[1]); oq.y = pk2(q2 * rsq * gq[2], q3 * rsq * gq[3]);
            *(u32x2*)((bf16_t*)(F.ws + WS_CQN) + (size_t)r * 256 + 4 * lane) = oq;
            const float k0 = bf_lo(kvw[u]), k1 = bf_hi(kvw[u]);
            const float rsk = 1.0f / sqrtf(wave_sum(k0 * k0 + k1 * k1, lane) * (1.f / 128.f) + EPS);
            *(unsigned*)((bf16_t*)(F.ws + WS_CKVN) + (size_t)r * 128 + 2 * lane) = pk2(k0 * rsk * kg0, k1 * rsk * kg1);
            const float xv = bf1(kr[u]);
            const float pv = shx(xv, 8, lane);
            const float o = (j & 8) ? (xv * cs[u].x + pv * cs[u].y) : (xv * cs[u].x - pv * cs[u].y);
            int b, t, kk; tok_tile(r, b, t, kk);
            if (lane < 32) { const bf16_t ob = (bf16_t)f2bf(o);
#pragma unroll
                for (int hh = 0; hh < 4; ++hh) *(bf16_t*)(F.ws + WS_MK + (size_t)((b * 4 + hh) * NTILE + t) * MKB + ktile_off(kk, 8 + (j >> 3)) + (j & 7) * 2) = ob; } }
    }
}

template <bool DRY>
__device__ __forceinline__ void phase_mergenorm(Frame& F, const Args& A, int l) {
    bf16_t* YC = (bf16_t*)(F.ws + WS_YC); bf16_t* YO = DRY ? (bf16_t*)(F.ws + WS_HB) : YC; const float* og = A.in[I_ONG] + l * D;
    constexpr int U = 4;
    f32x4 g[4];
#pragma unroll
    for (int i = 0; i < 4; ++i) g[i] = *(const f32x4*)(og + 4 * F.lane + 256 * i);
    for (int r0 = F.gw * U; r0 < MT; r0 += F.NGW * U) {
        u32x2 a[U][4];
#pragma unroll
        for (int u = 0; u < U; ++u)
#pragma unroll
            for (int i = 0; i < 4; ++i) a[u][i] = *(const u32x2*)(YC + (size_t)(r0 + u) * D + 4 * F.lane + 256 * i);
#pragma unroll
        for (int u = 0; u < U; ++u)
#pragma unroll
            for (int i = 0; i < 4; ++i) { const float v0 = bf_lo(a[u][i].x), v1 = bf_hi(a[u][i].x), v2 = bf_lo(a[u][i].y), v3 = bf_hi(a[u][i].y);
                const float rs = 1.0f / sqrtf(wave_sum((v0 * v0 + v1 * v1) + (v2 * v2 + v3 * v3), F.lane) * (1.f / 256.f) + EPS);
                u32x2 o; o.x = pk2(v0 * rs * g[i][0], v1 * rs * g[i][1]); o.y = pk2(v2 * rs * g[i][2], v3 * rs * g[i][3]); *(u32x2*)(YO + (size_t)(r0 + u) * D + 4 * F.lane + 256 * i) = o; }
    }
}

template <bool DRY>
__device__ __forceinline__ void phase_router(Frame& F, const Args& A, int l) {
    LAS float* rw = (LAS float*)F.lds;
    LAS int* lcnt = (LAS int*)(F.lds + LDS_MISC + 256);
    __syncthreads();
    if (F.tid < 64) lcnt[F.tid] = 0;
    { const f32x4* src = (const f32x4*)((const float*)(F.ws + WS_RW) + (size_t)l * 36 * 1024);
      for (int i = F.tid; i < 36 * 256; i += 512) ((LAS f32x4*)rw)[i] = src[i]; }
    __syncthreads();
    const int nrows = (l < NL - 1) ? MT : NLAT;
    const float* g = A.in[I_N2G] + l * D; const float* bgrp = A.in[I_BGRP] + l * 4; const float* bexp = A.in[I_BEXP] + l * NE;
    int* cnt = (int*)(F.ws + WS_CTL) + CW_CNT + l * NE * 64; int* list = (int*)(F.ws + WS_LIST); int* asg = (int*)(F.ws + WS_ASG); float* gate = (float*)(F.ws + WS_GATE);
    constexpr int U = 2;
    f32x4 xn[U][4];
    if (F.gw * U < nrows) load_x_rows<U>(F, A, F.gw * U, false, -1, xn, false);
    for (int r0 = F.gw * U; r0 < nrows; r0 += F.NGW * U) {
        f32x4 x[U][4];
#pragma unroll
        for (int u = 0; u < U; ++u)
#pragma unroll
            for (int i = 0; i < 4; ++i) x[u][i] = xn[u][i];
        if (r0 + F.NGW * U < nrows) load_x_rows<U>(F, A, r0 + F.NGW * U, false, -1, xn, false);
        float rs[U];
#pragma unroll
        for (int u = 0; u < U; ++u) rs[u] = row_rs(x[u], F.lane);
        const float* m = (const float*)(F.ws + WS_MOD) + ((size_t)l * 5 + mod_idx(r0)) * 6144;
#pragma unroll
        for (int i = 0; i < 4; ++i) { const int c = 4 * F.lane + 256 * i; const f32x4 gv = *(const f32x4*)(g + c), sc = *(const f32x4*)(m + 4096 + c), sh = *(const f32x4*)(m + 3072 + c);
#pragma unroll
            for (int u = 0; u < U; ++u) { x[u][i] = x[u][i] * rs[u] * gv * (sc + 1.f) + sh; u32x2 w; w.x = pk2(x[u][i][0], x[u][i][1]); w.y = pk2(x[u][i][2], x[u][i][3]); *(u32x2*)((bf16_t*)(F.ws + WS_HB) + (size_t)(r0 + u) * D + c) = w; } }
        float lg[U][4];
#pragma unroll
        for (int j = 0; j < 4; ++j) { float a[U];
#pragma unroll
            for (int u = 0; u < U; ++u) a[u] = 0.f;
#pragma unroll
            for (int i = 0; i < 4; ++i) { const f32x4 wv = *(const LAS f32x4*)(rw + j * 1024 + 4 * F.lane + 256 * i);
#pragma unroll
                for (int u = 0; u < U; ++u) a[u] += (x[u][i][0] * wv[0] + x[u][i][1] * wv[1]) + (x[u][i][2] * wv[2] + x[u][i][3] * wv[3]); }
#pragma unroll
            for (int u = 0; u < U; ++u) lg[u][j] = wave_sum(a[u], F.lane) + bgrp[j]; }
#pragma unroll
        for (int u = 0; u < U; ++u) { const int r = r0 + u;
            int gs = 0; float gm = lg[u][0];
#pragma unroll
            for (int j = 1; j < 4; ++j) if (lg[u][j] > gm) { gm = lg[u][j]; gs = j; }
            float se = 0.f;
#pragma unroll
            for (int j = 0; j < 4; ++j) se += __expf(lg[u][j] - gm);
            const float pg = 1.f / se;
            gs = __builtin_amdgcn_readfirstlane(gs);
            float el[8];
#pragma unroll
            for (int j = 0; j < 8; ++j) { float a = 0.f; const LAS float* wr_ = rw + (4 + gs * 8 + j) * 1024;
#pragma unroll
                for (int i = 0; i < 4; ++i) { const f32x4 wv = *(const LAS f32x4*)(wr_ + 4 * F.lane + 256 * i); a += (x[u][i][0] * wv[0] + x[u][i][1] * wv[1]) + (x[u][i][2] * wv[2] + x[u][i][3] * wv[3]); }
                el[j] = wave_sum(a, F.lane) + bexp[gs * 8 + j]; }
            int i1 = 0; float v1 = el[0];
#pragma unroll
            for (int j = 1; j < 8; ++j) if (el[j] > v1) { v1 = el[j]; i1 = j; }
            int i2 = 0; float v2 = -INFINITY;
#pragma unroll
            for (int j = 0; j < 8; ++j) if (j != i1 && el[j] > v2) { v2 = el[j]; i2 = j; }
            const float e2 = __expf(v2 - v1);
            const float w1 = 1.f / (1.f + e2), w2 = e2 / (1.f + e2);
            if (F.lane == 0 && (!DRY || w1 < -1.f)) {
                const int E1 = gs * 8 + i1, E2 = gs * 8 + i2;
                const int p1 = __hip_atomic_fetch_add(lcnt + E1, 1, __ATOMIC_RELAXED, __HIP_MEMORY_SCOPE_WORKGROUP), p2 = __hip_atomic_fetch_add(lcnt + E2, 1, __ATOMIC_RELAXED, __HIP_MEMORY_SCOPE_WORKGROUP);
                typedef int i32x4 __attribute__((ext_vector_type(4)));
                *(i32x4*)(asg + 4 * r) = (i32x4){E1, p1, E2, p2};
                *(f32x2*)(gate + 2 * r) = (f32x2){pg * w1, pg * w2};
            }
        }
    }
    __syncthreads();
    if (!DRY) {
        if (F.tid < NE) { const int c = lcnt[F.tid]; lcnt[32 + F.tid] = c ? atomicAdd(&cnt[F.tid * 64], c) : 0; }
        __syncthreads();
        asm volatile("s_waitcnt vmcnt(0)" ::: "memory");
        for (int r0 = F.gw * U; r0 < nrows; r0 += F.NGW * U) {
            if (F.lane < U) { const int r = r0 + F.lane; typedef int i32x4 __attribute__((ext_vector_type(4)));
                i32x4 a = *(const i32x4*)(asg + 4 * r); a[1] += lcnt[32 + a[0]]; a[3] += lcnt[32 + a[2]];
                *(i32x4*)(asg + 4 * r) = a; list[(size_t)a[0] * MT + a[1]] = r * 2; list[(size_t)a[2] * MT + a[3]] = r * 2 + 1; }
        }
    }
}
__device__ __forceinline__ void frame_ids(Frame& F) {
    { int t = (F.wave0 << 6) | lane_id(); asm volatile("" : "+v"(t)); F.tid = t; } F.lane = F.tid & 63; F.wave = __builtin_amdgcn_readfirstlane(F.tid >> 6);
    int bx = blockIdx.x; asm volatile("" : "+s"(bx));
    F.G = gridDim.x; F.vcu = (bx & 7) * (F.G >> 3) + (bx >> 3); F.bx = bx;
    F.gw = F.vcu * 8 + F.wave; F.NGW = F.G * 8;
}
__device__ __forceinline__ void phase_attn(Frame& F, const Args& A, int l) {
    const unsigned char* ws = F.ws;
    const bf16_t* Z = (const bf16_t*)(ws + WS_Z); const bf16_t* QM = (const bf16_t*)(ws + WS_QM); bf16_t* YC = (bf16_t*)(F.ws + WS_YC);
    LAS float* tab = (LAS float*)(F.lds + 81920);
    const int w = F.wave;
    const int nctx = (l < NL - 1) ? 16 : 0;
    for (int k = F.vcu; k < 512 + nctx; k += F.G) {
        frame_ids(F);
        const int uid = (F.G == 256 && k < 512) ? ((k & 255) * 2 + (k >> 8)) : k;
        NaInfo ni; ni.active_lo = 0; ni.active_hi = -1; ni.qrow = 0; ni.qcol = 0; ni.c0 = 0; ni.tab = tab;
        if (uid < 512) {
            const int b = uid >> 7, h = (uid >> 5) & 3, R0 = (uid & 31) * 4;
            __syncthreads();
            for (int j = F.tid; j < 15 * 128; j += 512) { int ix = (j & 127) - 48; ix = ix < 0 ? 0 : (ix > 30 ? 30 : ix); tab[j] = A.in[I_RPB][(size_t)(l * 4 + h) * 465 + (j >> 7) * 31 + ix] * LOG2E; }
            const int qrow = R0 + (w >> 1), qcol = 32 * (w & 1) + (F.lane & 31);
            const int bs = min(max(qrow - 4, 0), 120);
            ni.active_lo = bs; ni.active_hi = bs + 7; ni.qrow = qrow; ni.qcol = qcol; ni.c0 = min(max(qcol - 8, 0), 48);
            const int U0 = min(max(R0 - 4, 0), 120), U1 = min(max(R0 + 3 - 4, 0), 120) + 7;
            const int q0 = b * SEQ + qrow * 64 + 32 * (w & 1);
            const size_t tb = (size_t)(b * 4 + h) * NTILE;
            attn_unit<4, true, false>(F.lds, F.tid, Z + (size_t)q0 * ZP + 1280 + h * 64, ZP, ws + WS_NK + tb * NKB, ws + WS_NV + tb * VB, U0, U1 - U0 + 1, 4, YC + (size_t)q0 * D + 512 + h * 64, ni, nullptr);
        } else {
            const int cu = uid - 512, b = cu >> 2, h = cu & 3;
            const int q0 = NLAT + b * CTX + 32 * w;
            const size_t tb = (size_t)(b * 4 + h) * NTILE;
            attn_unit<4, false, false>(F.lds, F.tid, Z + (size_t)q0 * ZP + 1280 + h * 64, ZP, ws + WS_NK + tb * NKB, ws + WS_NV + tb * VB, 128, 4, 0, YC + (size_t)q0 * D + 512 + h * 64, ni, nullptr);
        }
    }
    frame_ids(F);
    for (int k = F.vcu; k < 512 + nctx; k += F.G) {
        frame_ids(F);
        const int uid = (F.G == 256 && k < 512) ? ((k & 255) * 2 + (k >> 8)) : k;
        NaInfo ni; ni.active_lo = 0; ni.active_hi = -1; ni.qrow = 0; ni.qcol = 0; ni.c0 = 0; ni.tab = tab;
        if (uid < 512) {
            const int b = uid >> 7, h = (uid >> 5) & 3, qb = uid & 31;
            const int q0 = b * SEQ + qb * 256 + 32 * w;
            const size_t tb = (size_t)(b * 4 + h) * NTILE;
            attn_unit<6, false, true>(F.lds, F.tid, QM + (size_t)q0 * 384 + h * 96, 384, ws + WS_MK + tb * MKB, ws + WS_MV + tb * VB, 0, NTILE, 0, YC + (size_t)q0 * D + 768 + h * 64, ni, (const float*)(ws + WS_ROPE) + (size_t)(q0 & 8191) * 32);
        } else {
            const int cu = uid - 512, b = cu >> 2, h = cu & 3;
            const int q0 = NLAT + b * CTX + 32 * w;
            const size_t tb = (size_t)(b * 4 + h) * NTILE;
            attn_unit<6, false, false>(F.lds, F.tid, QM + (size_t)q0 * 384 + h * 96, 384, ws + WS_MK + tb * MKB, ws + WS_MV + tb * VB, 128, 4, 0, YC + (size_t)q0 * D + 768 + h * 64, ni, nullptr);
        }
    }
}

__device__ __forceinline__ void outproj_ctx(Frame& F, const bf16_t* YC, const bf16_t* Bt, const float* res, float* xo, const float* g1c) {
    for (int t = F.vcu; t < 256; t += F.G) {
        const int tr = t >> 4, tc = t & 15, fr = F.lane & 15, fq = F.lane >> 4;
        const int r = tr * 64 + (F.wave >> 1) * 16 + fr, n0 = tc * 64 + (F.wave & 1) * 32;
        const bf16_t* ap = YC + (size_t)(NLAT + r) * D + 8 * fq;
        const bf16_t* bp0 = Bt + (size_t)(n0 + fr) * D + 8 * fq;
        const bf16_t* bp1 = bp0 + (size_t)16 * D;
        f32x4 c0 = {0.f, 0.f, 0.f, 0.f}, c1 = {0.f, 0.f, 0.f, 0.f};
#pragma unroll 4
        for (int k = 0; k < D; k += 32) {
            const bf16x8 a = *(const bf16x8*)(ap + k), b0 = *(const bf16x8*)(bp0 + k), b1 = *(const bf16x8*)(bp1 + k);
            c0 = __builtin_amdgcn_mfma_f32_16x16x32_bf16(b0, a, c0, 0, 0, 0);
            c1 = __builtin_amdgcn_mfma_f32_16x16x32_bf16(b1, a, c1, 0, 0, 0);
        }
        const size_t off = (size_t)r * D + n0 + 4 * fq;
        const f32x4 g0 = *(const f32x4*)(g1c + n0 + 4 * fq), g1 = *(const f32x4*)(g1c + n0 + 16 + 4 * fq);
        const f32x4 r0 = *(const f32x4*)(res + off), r1 = *(const f32x4*)(res + off + 16);
        *(f32x4*)(xo + off) = r0 + g0 * c0; *(f32x4*)(xo + off + 16) = r1 + g1 * c1;
    }
}

__global__ void __launch_bounds__(512, 2) fwd(Args args) {
    extern __shared__ __attribute__((aligned(16))) unsigned char lds_raw[];
    Frame F;
    F.lds = (LAS unsigned char*)lds_raw; F.ws = args.ws; F.out = args.out;
    F.wave0 = __builtin_amdgcn_readfirstlane((int)threadIdx.x >> 6);
    frame_ids(F);
    volatile LAS unsigned* MISC = (volatile LAS unsigned*)(F.lds + LDS_MISC);
    if (F.tid < 64) MISC[F.tid] = 0u;
    __syncthreads();
    XcdBarrier bar; bar.bar = (unsigned*)(args.ws + WS_CTL) + CW_BAR; bar.x = 0; bar.st = nullptr;
    if (args.flags & 4) bar = xcd_barrier_post((unsigned*)(args.ws + WS_CTL) + CW_BAR, MISC + 8, F.tid);
#define GRID_BAR() do { if (args.flags & 4) xcd_barrier(bar, (F.wave0 << 6) | lane_id()); } while (0)
#ifndef DUP_MASK
#define DUP_MASK 0
#endif
#define REP(k) for (int rep_ = 0; rep_ < (((DUP_MASK >> (k)) & 1) ? 2 : 1); ++rep_)
#ifndef PHASE_MASK
#define PHASE_MASK 0xFFFF
#endif
#define IN(k) (((PHASE_MASK >> (k)) & 1) && args.ph_lo <= (k) && (k) < args.ph_hi)
#ifdef TS_PHASE
#ifndef TS_Q
#define TS_Q 250.f
#endif
#ifndef TS_OFF
#define TS_OFF 0
#endif
    const unsigned long long ts0_ = __builtin_amdgcn_s_memrealtime();
    float ts_us_ = 0.f;
#define TS_MARK(ph, lay) do { if ((ph) == TS_PHASE && (lay) == TS_LAYER) { const float t_ = (float)(__builtin_amdgcn_s_memrealtime() - ts0_) * 0.01f + (float)TS_OFF; ts_us_ = floorf(t_ * (1.f / TS_Q)) * TS_Q + 0.5f * TS_Q; } } while (0)
#else
#define TS_MARK(ph, lay) do {} while (0)
#endif
    if ((PHASE_MASK & 1) && (args.flags & 1)) REP(0) { frame_ids(F); phase_prologue(F, args); GRID_BAR(); }
    TS_MARK(0, 0);
#define LAUNDER() GAS unsigned char* wsg_ = (GAS unsigned char*)args.ws; asm volatile("" : "+s"(wsg_)); unsigned char* ws = (unsigned char*)wsg_; int l = l_; asm volatile("" : "+s"(l)); F.ws = ws; frame_ids(F)
    for (int l_ = args.l_lo; l_ < args.l_hi; ++l_) {
#if (DUP_MASK >> 1) & 1
        if (IN(1)) { LAUNDER(); phase_norm1<true>(F, args, l); GRID_BAR(); }
#endif
        if (IN(1)) { LAUNDER(); phase_norm1<false>(F, args, l); GRID_BAR(); }
        TS_MARK(1, l_);
        if (IN(2)) REP(2) { LAUNDER();
            pg8::Gemm g{(const bf16_t*)(ws + WS_HB), (const bf16_t*)(ws + WS_WIN) + (size_t)l * ZP * D, D, D};
            pg8::StaticOrder S; S.init(MT, ZP, F.G, F.bx); pg8::PlainRows AR{D * 2};
            EpiZ E{(bf16_t*)(ws + WS_Z), ws + WS_NK, ws + WS_NV};
            pg8::gemm_phase<EpiZ, pg8::StaticOrder, pg8::PlainRows, true, true>(F.lds, F.tid, g, S, AR, E);
            GRID_BAR();
        }
        TS_MARK(2, l_);
#if (DUP_MASK >> 3) & 1
        if (IN(3)) { { LAUNDER(); phase_conv(F, args, l); __syncthreads(); frame_ids(F); phase_sg(F, args, l); __syncthreads(); frame_ids(F); phase_mlaprep(F, args, l); GRID_BAR(); }
                     { LAUNDER(); phase_conv(F, args, l); __syncthreads(); frame_ids(F); phase_sg(F, args, l); __syncthreads(); frame_ids(F); phase_mlaprep(F, args, l); GRID_BAR(); } }
#else
        if (IN(3)) { LAUNDER(); phase_conv(F, args, l); __syncthreads(); frame_ids(F); phase_sg(F, args, l); __syncthreads(); frame_ids(F); phase_mlaprep(F, args, l); GRID_BAR(); }
#endif
        TS_MARK(3, l_);
        if (IN(4)) REP(4) { LAUNDER();
            { pg8::Gemm g{(const bf16_t*)(ws + WS_CQN), (const bf16_t*)(ws + WS_WUQ) + (size_t)l * 512 * 256, 256, 256};
              pg8::StaticOrder S; S.init(MT, 512, F.G, F.bx); pg8::PlainRows AR{256 * 2};
              EpiQ E{(bf16_t*)(ws + WS_QM)};
              pg8::gemm_phase<EpiQ, pg8::StaticOrder, pg8::PlainRows, true, true>(F.lds, F.tid, g, S, AR, E); }
            frame_ids(F);
            { pg8::Gemm g{(const bf16_t*)(ws + WS_CKVN), (const bf16_t*)(ws + WS_WUKV) + (size_t)l * 512 * 128, 128, 128};
              pg8::StaticOrder S; S.init(MT, 512, F.G, (F.G - 1 - F.bx)); pg8::PlainRows AR{128 * 2};
              EpiKV E{ws + WS_MK, ws + WS_MV};
              pg8::gemm_phase<EpiKV, pg8::StaticOrder, pg8::PlainRows, true, true>(F.lds, F.tid, g, S, AR, E); }
            GRID_BAR();
        }
        TS_MARK(4, l_);
#if (DUP_MASK >> 5) & 1
        if (IN(5)) { { LAUNDER(); phase_attn(F, args, l); GRID_BAR(); } { LAUNDER(); phase_attn(F, args, l); GRID_BAR(); } }
#else
        if (IN(5)) { LAUNDER(); phase_attn(F, args, l); GRID_BAR(); }
#endif
        TS_MARK(5, l_);
#if (DUP_MASK >> 6) & 1
        if (IN(6)) { LAUNDER(); phase_mergenorm<true>(F, args, l); GRID_BAR(); }
#endif
        if (IN(6)) { LAUNDER(); phase_mergenorm<false>(F, args, l); GRID_BAR(); }
        TS_MARK(6, l_);
#if (DUP_MASK >> 7) & 1
        if (IN(7)) { LAUNDER();
            pg8::Gemm g{(const bf16_t*)(ws + WS_YC), (const bf16_t*)(ws + WS_WOUT) + (size_t)l * D * D, D, D};
            pg8::StaticOrder S; S.init(MT, D, F.G, F.bx); pg8::PlainRows AR{D * 2};
            EpiOut E{l == 0 ? args.in[I_X] : args.out, l == 0 ? args.in[I_CTX] : (const float*)(ws + WS_XC), (float*)(ws + WS_Z), (float*)(ws + WS_Z) + (size_t)NLAT * D, (const float*)(ws + WS_MOD) + (size_t)l * 5 * 6144 + 2048};
            pg8::gemm_phase<EpiOut, pg8::StaticOrder, pg8::PlainRows, true, true>(F.lds, F.tid, g, S, AR, E);
            GRID_BAR();
        }
#endif
        if (IN(7)) { LAUNDER();
            pg8::Gemm g{(const bf16_t*)(ws + WS_YC), (const bf16_t*)(ws + WS_WOUT) + (size_t)l * D * D, D, D};
            pg8::StaticOrder S; S.init(NLAT, D, F.G, F.bx); pg8::PlainRows AR{D * 2};
            EpiOut E{l == 0 ? args.in[I_X] : args.out, l == 0 ? args.in[I_CTX] : (const float*)(ws + WS_XC), args.out, (float*)(ws + WS_XC), (const float*)(ws + WS_MOD) + (size_t)l * 5 * 6144 + 2048};
            pg8::gemm_phase<EpiOut, pg8::StaticOrder, pg8::PlainRows, true, true>(F.lds, F.tid, g, S, AR, E);
            if (l < NL - 1) { LAUNDER(); outproj_ctx(F, (const bf16_t*)(ws + WS_YC), (const bf16_t*)(ws + WS_WOUT) + (size_t)l * D * D, l == 0 ? args.in[I_CTX] : (const float*)(ws + WS_XC), (float*)(ws + WS_XC), (const float*)(ws + WS_MOD) + (size_t)l * 5 * 6144 + 2048 + 4 * 6144); }
            GRID_BAR();
        }
        TS_MARK(7, l_);
#if (DUP_MASK >> 8) & 1
        if (IN(8)) { LAUNDER(); phase_router<true>(F, args, l); GRID_BAR(); }
#endif
        if (IN(8)) { LAUNDER(); phase_router<false>(F, args, l); GRID_BAR(); }
        TS_MARK(8, l_);
        if (IN(9)) REP(9) { LAUNDER();
            moe_tables(F, args, l);
            const LAS int* tb = (const LAS int*)(F.lds + LDS_MOE);
            pg8::Gemm g{(const bf16_t*)(ws + WS_HB), (const bf16_t*)(ws + WS_W1) + (size_t)l * NE * 1024 * 1024, D, D};
            MoeOrder S{tb, F.G, F.bx}; MoeRows1 AR{D * 2, tb, tb + 64, (const int*)(ws + WS_LIST)};
            EpiMoe1 E{(bf16_t*)(ws + WS_H1)};
            pg8::gemm_phase<EpiMoe1, MoeOrder, MoeRows1, true, true>(F.lds, F.tid, g, S, AR, E);
            GRID_BAR();
        }
        TS_MARK(9, l_);
        if (IN(10)) REP(10) { LAUNDER();
            moe_tables(F, args, l);
            const LAS int* tb = (const LAS int*)(F.lds + LDS_MOE);
            pg8::Gemm g{(const bf16_t*)(ws + WS_H1), (const bf16_t*)(ws + WS_W2) + (size_t)l * NE * 1024 * 512, DE, DE};
            MoeOrder S{tb, F.G, F.bx}; pg8::PlainRows AR{DE * 2};
            EpiMoe2 E{(bf16_t*)(ws + WS_Y)};
            pg8::gemm_phase<EpiMoe2, MoeOrder, pg8::PlainRows, true, true>(F.lds, F.tid, g, S, AR, E);
            GRID_BAR();
        }
        TS_MARK(10, l_);
    }
    if (((PHASE_MASK >> 11) & 1) && (args.flags & 2)) { frame_ids(F); phase_final(F, args); }
#ifdef TS_PHASE
    TS_MARK(11, 0);
    if (blockIdx.x == 0) { __syncthreads(); asm volatile("s_waitcnt vmcnt(0)" ::: "memory"); if (F.tid == 0) args.out[0] = ts_us_; }
#endif
#undef IN
#undef GRID_BAR
}
}

#ifndef MK_ONE_LAUNCH
#define MK_ONE_LAUNCH 1
#endif
extern "C" void kernel_launch(void* const* d_in, const int* in_sizes, int n_in, void* d_out, int out_size, void* d_ws, size_t ws_size, hipStream_t stream) {
    using namespace mk;
    static int grid = 0;
    if (grid == 0) {
        if (n_in != 27 || ws_size < WS_END) { fprintf(stderr, "kernel_launch: unexpected inputs (n_in %d, ws %zu)\n", n_in, ws_size); grid = -1; return; }
        int dev = 0, cus = 0;
        if (hipGetDevice(&dev) != hipSuccess || hipDeviceGetAttribute(&cus, hipDeviceAttributeMultiprocessorCount, dev) != hipSuccess) { grid = -1; return; }
        if (hipFuncSetAttribute((const void*)fwd, hipFuncAttributeMaxDynamicSharedMemorySize, LDS_BYTES) != hipSuccess) { fprintf(stderr, "kernel_launch: hipFuncSetAttribute failed\n"); grid = -1; return; }
        int per_cu = 0;
        if (hipOccupancyMaxActiveBlocksPerMultiprocessor(&per_cu, (const void*)fwd, 512, LDS_BYTES) != hipSuccess || per_cu < 1) fprintf(stderr, "kernel_launch: occupancy query says %d\n", per_cu);
        (void)hipGetLastError();
        grid = cus & ~7;
    }
    if (grid < 0) return;
    if (hipMemsetAsync((char*)d_ws + WS_CTL, 0, CTL_BYTES, stream) != hipSuccess) return;
    Args a; memset(&a, 0, sizeof(a));
    for (int i = 0; i < 27; ++i) a.in[i] = (const float*)d_in[i];
    a.out = (float*)d_out; a.ws = (unsigned char*)d_ws;
#if MK_ONE_LAUNCH
    a.l_lo = 0; a.l_hi = NL; a.ph_lo = 1; a.ph_hi = 11; a.flags = 1 | 2 | 4;
    hipLaunchKernelGGL(fwd, dim3(grid), dim3(512), LDS_BYTES, stream, a);
#else
    a.l_lo = 0; a.l_hi = 0; a.ph_lo = 0; a.ph_hi = 0; a.flags = 1;
    hipLaunchKernelGGL(fwd, dim3(grid), dim3(512), LDS_BYTES, stream, a);
    for (int l = 0; l < NL; ++l)
        for (int ph = 1; ph <= 10; ++ph) { a.l_lo = l; a.l_hi = l + 1; a.ph_lo = ph; a.ph_hi = ph + 1; a.flags = 0; hipLaunchKernelGGL(fwd, dim3(grid), dim3(512), LDS_BYTES, stream, a); }
    a.l_lo = 0; a.l_hi = 0; a.ph_lo = 0; a.ph_hi = 0; a.flags = 2;
    hipLaunchKernelGGL(fwd, dim3(grid), dim3(512), LDS_BYTES, stream, a);
#endif
}
```
